# Optimizing an MI355X kernel written in HIP

```python
import math
import jax, jax.numpy as jnp
from jax import lax
import numpy as np

D_MODEL = 4096
BATCH = 4
SEQ = 4096
DEPTH = 4

GRID_W = 64
CTX_LEN = 256
HEAD_DIM = 128
N_HEADS_TOTAL = D_MODEL // HEAD_DIM
A_Q_HEADS = N_HEADS_TOTAL // 2
A_KV_HEADS = A_Q_HEADS // 4
A_GROUP = A_Q_HEADS // A_KV_HEADS
B_HEADS = N_HEADS_TOTAL // 4
NA_ROWS = 8
NA_COLS = 16
C_HEADS = N_HEADS_TOTAL // 4
C_QK_DIM = HEAD_DIM // 2
C_V_DIM = HEAD_DIM
A_Q_W = A_Q_HEADS * HEAD_DIM
A_KV_W = A_KV_HEADS * HEAD_DIM
B_W = B_HEADS * HEAD_DIM
C_QK_W = C_HEADS * 2 * C_QK_DIM
C_V_W = C_HEADS * C_V_DIM
GATE_RANK = 512
IN_W = A_Q_W + 2 * A_KV_W + 3 * B_W + 2 * C_QK_W + C_V_W + GATE_RANK
MIX_W = A_Q_W + B_W + C_V_W
N_BRANCH = 3
ADA_RANK = 256
D_FF = 256 * ((8 * D_MODEL + 3 * 256 - 1) // (3 * 256))
Q_BLOCK = 128
ROPE_THETA = 10000.0
EPS = 1e-6

kernel_name = "hybrid_gqa_natten_diffattn_dit_trunk"


def _rms_norm(x, g):
    xf = x.astype(jnp.float32)
    y = xf * lax.rsqrt(jnp.mean(xf * xf, axis=-1, keepdims=True) + EPS)
    return (y * g.astype(jnp.float32)).astype(x.dtype)


def _adaln(cond, w_down, w_up, b):
    mod = (jax.nn.silu(cond) @ w_down) @ w_up + b
    return jnp.split(mod, 6, axis=-1)


def _modulate(h, shift, scale):
    return h * (1 + scale[:, None, :]) + shift[:, None, :]


def _axial_rope_angles(n_tokens, dim):
    t = jnp.arange(n_tokens)
    rows = (t // GRID_W).astype(jnp.float32)
    cols = (t % GRID_W).astype(jnp.float32)
    n_pairs = dim // 4
    freqs = ROPE_THETA ** (-jnp.arange(n_pairs, dtype=jnp.float32) / n_pairs)
    return jnp.concatenate([rows[:, None] * freqs, cols[:, None] * freqs], axis=-1)


def _apply_rope(x, ang):
    half = x.shape[-1] // 2
    xf = x.astype(jnp.float32).reshape(x.shape[:-1] + (half, 2))
    bshape = (1, ang.shape[0]) + (1,) * (x.ndim - 3) + (half,)
    cos = jnp.cos(ang).reshape(bshape)
    sin = jnp.sin(ang).reshape(bshape)
    x0, x1 = xf[..., 0], xf[..., 1]
    out = jnp.stack([x0 * cos - x1 * sin, x0 * sin + x1 * cos], axis=-1)
    return out.reshape(x.shape).astype(x.dtype)


def _sweep_query_blocks(fn, q):
    b, s = q.shape[:2]
    nblk = s // Q_BLOCK
    qb = jnp.moveaxis(q.reshape((b, nblk, Q_BLOCK) + q.shape[2:]), 1, 0)
    ob = lax.map(fn, qb)
    return jnp.moveaxis(ob, 0, 1).reshape((b, s) + ob.shape[3:])


def _attend_gqa(q, k, v):
    s = jnp.einsum("bqhgd,bkhd->bhgqk", q, k).astype(jnp.float32) * (q.shape[-1] ** -0.5)
    p = jax.nn.softmax(s, axis=-1).astype(v.dtype)
    return jnp.einsum("bhgqk,bkhd->bqhgd", p, v)


def _attend_diff(q, k, v, lam):
    s = jnp.einsum("bqhcd,bkhcd->bhcqk", q, k).astype(jnp.float32) * (q.shape[-1] ** -0.5)
    p = jax.nn.softmax(s, axis=-1)
    w = (p[:, :, 0] - lam * p[:, :, 1]).astype(v.dtype)
    return jnp.einsum("bhqk,bkhe->bqhe", w, v)


def _neighbourhood_attention(q, k, v, k_ctx, v_ctx, rpb):
    b, s, h, d = q.shape
    rows = s // GRID_W
    kr = min(NA_ROWS, rows)
    c = np.arange(GRID_W)
    c0 = np.clip(c - NA_COLS // 2, 0, GRID_W - NA_COLS)
    col_mask = jnp.asarray((c[None, :] >= c0[:, None]) & (c[None, :] < c0[:, None] + NA_COLS))
    col_idx = jnp.asarray(np.clip(c[None, :] - c[:, None] + NA_COLS - 1, 0, 2 * NA_COLS - 2))
    q_grid = q.reshape(b, rows, GRID_W, h, d)
    k_grid = k.reshape(b, rows, GRID_W, h, d)
    v_grid = v.reshape(b, rows, GRID_W, h, d)
    scale = d ** -0.5

    def row_block(xs):
        r, q_row = xs
        r0 = jnp.clip(r - kr // 2, 0, rows - kr)
        k_blk = lax.dynamic_slice_in_dim(k_grid, r0, kr, axis=1)
        v_blk = lax.dynamic_slice_in_dim(v_grid, r0, kr, axis=1)
        s_loc = jnp.einsum("bqhd,biwhd->bhqiw", q_row, k_blk).astype(jnp.float32) * scale
        dr = r0 + jnp.arange(kr) - r + (NA_ROWS - 1)
        bias = jnp.transpose(rpb[:, dr][:, :, col_idx], (0, 2, 1, 3)).astype(jnp.float32)
        s_loc = jnp.where(col_mask[:, None, :], s_loc + bias, -jnp.inf)
        s_ctx = jnp.einsum("bqhd,bchd->bhqc", q_row, k_ctx).astype(jnp.float32) * scale
        s_all = jnp.concatenate([s_loc.reshape(b, h, GRID_W, kr * GRID_W), s_ctx], axis=-1)
        p = jax.nn.softmax(s_all, axis=-1).astype(v.dtype)
        p_loc = p[..., : kr * GRID_W].reshape(b, h, GRID_W, kr, GRID_W)
        p_ctx = p[..., kr * GRID_W:]
        return (jnp.einsum("bhqiw,biwhd->bqhd", p_loc, v_blk)
                + jnp.einsum("bhqc,bchd->bqhd", p_ctx, v_ctx))

    out = lax.map(row_block, (jnp.arange(rows), jnp.moveaxis(q_grid, 1, 0)))
    return jnp.moveaxis(out, 0, 1).reshape(b, s, h * d)


def _project(h, w):
    b, s = h.shape[:2]
    sizes = [A_Q_W, A_KV_W, A_KV_W, B_W, B_W, B_W, C_QK_W, C_QK_W, C_V_W, GATE_RANK]
    offsets = [int(o) for o in np.cumsum(sizes)[:-1]]
    a_q, a_k, a_v, b_q, b_k, b_v, c_q, c_k, c_v, g_low = jnp.split(h @ w, offsets, axis=-1)
    return (a_q.reshape(b, s, A_KV_HEADS, A_GROUP, HEAD_DIM),
            a_k.reshape(b, s, A_KV_HEADS, HEAD_DIM),
            a_v.reshape(b, s, A_KV_HEADS, HEAD_DIM),
            b_q.reshape(b, s, B_HEADS, HEAD_DIM),
            b_k.reshape(b, s, B_HEADS, HEAD_DIM),
            b_v.reshape(b, s, B_HEADS, HEAD_DIM),
            c_q.reshape(b, s, C_HEADS, 2, C_QK_DIM),
            c_k.reshape(b, s, C_HEADS, 2, C_QK_DIM),
            c_v.reshape(b, s, C_HEADS, C_V_DIM),
            g_low)


def _merge(g_low, o_a, o_b, o_c, w_gate_up, b_gate, w_branch, w_out):
    gates = jax.nn.sigmoid((g_low @ w_gate_up + b_gate).astype(jnp.float32)).astype(o_a.dtype)
    g_a, g_b, g_c = jnp.split(gates, N_BRANCH, axis=-1)
    merged = (g_a * (o_a @ w_branch[:A_Q_W])
              + g_b * (o_b @ w_branch[A_Q_W:A_Q_W + B_W])
              + g_c * (o_c @ w_branch[A_Q_W + B_W:]))
    return merged @ w_out


def _swiglu(h, w_in, w_out):
    gate, up = jnp.split(h @ w_in, 2, axis=-1)
    return (jax.nn.silu(gate) * up) @ w_out


def setup_inputs(seed: int = 0) -> dict:
    key = jax.random.key(seed)
    ks = jax.random.split(key, 26)
    f32 = jnp.float32
    L, D = DEPTH, D_MODEL

    def nrm(k, shape, scale):
        return jax.random.normal(k, shape, f32) * scale

    def gain(k, shape):
        return 1.0 + 0.02 * jax.random.normal(k, shape, f32)

    return {
        "x": nrm(ks[0], (BATCH, SEQ, D), 1.0),
        "c": nrm(ks[1], (BATCH, D), 1.0),
        "ctx": nrm(ks[2], (BATCH, CTX_LEN, D), 1.0),
        "c_ctx": nrm(ks[3], (D,), 1.0),
        "ada_down": nrm(ks[4], (L, D, ADA_RANK), D ** -0.5),
        "ada_up": nrm(ks[5], (L, ADA_RANK, 6 * D), ADA_RANK ** -0.5),
        "ada_bias": nrm(ks[6], (L, 6 * D), 0.02),
        "norm_mix_pre": gain(ks[7], (L, D)),
        "norm_mix_post": gain(ks[8], (L, D)),
        "norm_ffn_pre": gain(ks[9], (L, D)),
        "norm_ffn_post": gain(ks[10], (L, D)),
        "w_in": nrm(ks[11], (L, D, IN_W), D ** -0.5),
        "a_q_norm": gain(ks[12], (L, HEAD_DIM)),
        "a_k_norm": gain(ks[13], (L, HEAD_DIM)),
        "b_rel_bias": nrm(ks[14], (L, B_HEADS, 2 * NA_ROWS - 1, 2 * NA_COLS - 1), 0.1),
        "c_lambda_q1": nrm(ks[15], (L, C_QK_DIM), 0.1),
        "c_lambda_k1": nrm(ks[16], (L, C_QK_DIM), 0.1),
        "c_lambda_q2": nrm(ks[17], (L, C_QK_DIM), 0.1),
        "c_lambda_k2": nrm(ks[18], (L, C_QK_DIM), 0.1),
        "c_subln": gain(ks[19], (L, C_V_DIM)),
        "w_gate_up": nrm(ks[20], (L, GATE_RANK, N_BRANCH * D), GATE_RANK ** -0.5),
        "b_gate": nrm(ks[21], (L, N_BRANCH * D), 0.02),
        "w_branch": nrm(ks[22], (L, MIX_W, D), MIX_W ** -0.5),
        "w_out": nrm(ks[23], (L, D, D), D ** -0.5),
        "w_ffn_in": nrm(ks[24], (L, D, 2 * D_FF), D ** -0.5),
        "w_ffn_out": nrm(ks[25], (L, D_FF, D), D_FF ** -0.5),
    }


def reference(x, c, ctx, c_ctx, ada_down, ada_up, ada_bias, norm_mix_pre, norm_mix_post,
              norm_ffn_pre, norm_ffn_post, w_in, a_q_norm, a_k_norm, b_rel_bias,
              c_lambda_q1, c_lambda_k1, c_lambda_q2, c_lambda_k2, c_subln,
              w_gate_up, b_gate, w_branch, w_out, w_ffn_in, w_ffn_out):
    b, s = x.shape[:2]
    n_ctx = ctx.shape[1]
    ang_a = _axial_rope_angles(s, HEAD_DIM)
    ang_c = _axial_rope_angles(s, C_QK_DIM)
    for l in range(DEPTH):
        last = l == DEPTH - 1
        sh1_x, sc1_x, g1_x, sh2_x, sc2_x, g2_x = _adaln(c, ada_down[l], ada_up[l], ada_bias[l])
        sh1_c, sc1_c, g1_c, sh2_c, sc2_c, g2_c = _adaln(c_ctx[None], ada_down[l], ada_up[l], ada_bias[l])

        h_x = _modulate(_rms_norm(x, norm_mix_pre[l]), sh1_x, sc1_x)
        h_c = _modulate(_rms_norm(ctx, norm_mix_pre[l]), sh1_c, sc1_c)
        aq_x, ak_x, av_x, bq_x, bk_x, bv_x, cq_x, ck_x, cv_x, gl_x = _project(h_x, w_in[l])
        aq_c, ak_c, av_c, bq_c, bk_c, bv_c, cq_c, ck_c, cv_c, gl_c = _project(h_c, w_in[l])

        aq_x = _apply_rope(_rms_norm(aq_x, a_q_norm[l]), ang_a)
        ak_x = _apply_rope(_rms_norm(ak_x, a_k_norm[l]), ang_a)
        aq_c = _rms_norm(aq_c, a_q_norm[l])
        ak_c = _rms_norm(ak_c, a_k_norm[l])
        k_all_a = jnp.concatenate([ak_c, ak_x], axis=1)
        v_all_a = jnp.concatenate([av_c, av_x], axis=1)
        oa_x = _sweep_query_blocks(lambda qb: _attend_gqa(qb, k_all_a, v_all_a), aq_x).reshape(b, s, A_Q_W)

        ob_x = _neighbourhood_attention(bq_x, bk_x, bv_x, bk_c, bv_c, b_rel_bias[l])

        lam_init = 0.8 - 0.6 * math.exp(-0.3 * l)
        lam = (jnp.exp(jnp.sum(c_lambda_q1[l].astype(jnp.float32) * c_lambda_k1[l].astype(jnp.float32)))
               - jnp.exp(jnp.sum(c_lambda_q2[l].astype(jnp.float32) * c_lambda_k2[l].astype(jnp.float32)))
               + lam_init)
        cq_x = _apply_rope(cq_x, ang_c)
        ck_x = _apply_rope(ck_x, ang_c)
        k_all_c = jnp.concatenate([ck_c, ck_x], axis=1)
        v_all_c = jnp.concatenate([cv_c, cv_x], axis=1)
        oc_x = _sweep_query_blocks(lambda qb: _attend_diff(qb, k_all_c, v_all_c, lam), cq_x)
        oc_x = (_rms_norm(oc_x, c_subln[l]) * (1 - lam_init)).reshape(b, s, C_V_W)

        mix_x = _merge(gl_x, oa_x, ob_x, oc_x, w_gate_up[l], b_gate[l], w_branch[l], w_out[l])
        x = x + g1_x[:, None, :] * _rms_norm(mix_x, norm_mix_post[l])

        f_x = _swiglu(_modulate(_rms_norm(x, norm_ffn_pre[l]), sh2_x, sc2_x), w_ffn_in[l], w_ffn_out[l])
        x = x + g2_x[:, None, :] * _rms_norm(f_x, norm_ffn_post[l])

        if not last:
            oa_c = _attend_gqa(aq_c, ak_c, av_c).reshape(b, n_ctx, A_Q_W)
            ob_c = _attend_gqa(bq_c[:, :, :, None], bk_c, bv_c).reshape(b, n_ctx, B_W)
            oc_c = (_rms_norm(_attend_diff(cq_c, ck_c, cv_c, lam), c_subln[l]) * (1 - lam_init)).reshape(b, n_ctx, C_V_W)
            mix_c = _merge(gl_c, oa_c, ob_c, oc_c, w_gate_up[l], b_gate[l], w_branch[l], w_out[l])
            ctx = ctx + g1_c[:, None, :] * _rms_norm(mix_c, norm_mix_post[l])
            f_c = _swiglu(_modulate(_rms_norm(ctx, norm_ffn_pre[l]), sh2_c, sc2_c), w_ffn_in[l], w_ffn_out[l])
            ctx = ctx + g2_c[:, None, :] * _rms_norm(f_c, norm_ffn_post[l])
    return x
```

```cpp
#include <hip/hip_runtime.h>
#include <cstdio>
#include <cstdint>

#ifndef PHM
#define PHM 0xffff
#endif
#ifndef MK_PER_PHASE
#define MK_PER_PHASE 1
#endif

__device__ __forceinline__ int opaque_tid() { int t = threadIdx.x; asm volatile("" : "+v"(t)); return t; }
namespace pg8 {
#define PG8_LAS __attribute__((address_space(3)))
typedef unsigned short bf16_t;
typedef short bf16x8 __attribute__((ext_vector_type(8)));
typedef float f32x4 __attribute__((ext_vector_type(4)));
typedef unsigned u32x4 __attribute__((ext_vector_type(4)));
constexpr int BM = 256, BK = 64, HALF = 128, HTB = HALF * BK * 2, STAGE_BYTES = 8 * HTB, NXCD = 8, WGM = 8;

__host__ __device__ __forceinline__ int lds_byte(int r, int c) { const int st = (r >> 4) * 2 + (c >> 5), rr = r & 15, cc = c & 31, ob = rr * 64 + cc * 2; return st * 1024 + (ob ^ (((ob >> 9) & 1) << 5)); }
__host__ __device__ __forceinline__ void stage_rc(int b, int& R, int& C) { const int st = b / 1024, sb = b % 1024, swz = sb ^ (((sb >> 9) & 1) << 5); R = (st >> 1) * 16 + swz / 64; C = (st & 1) * 32 + (swz % 64) / 2; }
__host__ __device__ __forceinline__ int perm32(int rho) { const int n = rho >> 4, i = rho & 15; return 8 * (i >> 2) + 4 * n + (i & 3); }

struct Unit { int pm, pn; };
struct Gemm { const bf16_t* A; const bf16_t* Bt; int M, N, K, lda; };

struct StaticOrder {
    int nM, nN, nwg, G, c;
    __host__ __device__ void init(int M, int N, int G_, int c_) { nM = M / BM; nN = N / BM; nwg = nM * nN; G = G_; c = c_; }
    __host__ __device__ bool next(int i, Unit& u) const {
        const long L = (long)i * G + c; if (L >= nwg) return false;
        int wgid = (int)L; { const int q = nwg / NXCD, r = nwg % NXCD, xcd = wgid % NXCD, off = wgid / NXCD; wgid = (xcd < r ? xcd * (q + 1) : r * (q + 1) + (xcd - r) * q) + off; }
        const int nig = WGM * nN, gid = wgid / nig, fm = gid * WGM, gsz = (nM - fm) < WGM ? (nM - fm) : WGM;
        u.pm = fm + ((wgid % nig) % gsz); u.pn = (wgid % nig) / gsz; return true;
    }
    __device__ __forceinline__ void a_ready(const Unit&) const {}
    __device__ __forceinline__ void done(const Unit&) const {}
};

__device__ __forceinline__ unsigned cvt_pk_bf16(float lo, float hi) { unsigned r; asm volatile("v_cvt_pk_bf16_f32 %0, %1, %2" : "=v"(r) : "v"(lo), "v"(hi)); return r; }
__device__ __forceinline__ float sigm(float x) { return __builtin_amdgcn_rcpf(1.0f + __builtin_amdgcn_exp2f(-1.4426950408889634f * x)); }
__device__ __forceinline__ f32x4 bf4lo(unsigned a, unsigned b) { return (f32x4){__uint_as_float(a << 16), __uint_as_float(a & 0xffff0000u), __uint_as_float(b << 16), __uint_as_float(b & 0xffff0000u)}; }

template <int ACT> struct EpiBf16 {
    static constexpr bool PERM = true, AFTER_DRAIN = false, HORNER = false;
    bf16_t* O; int ldc; const float* bias;
    __device__ __forceinline__ void mid(f32x4 (&)[2][2][4][2], const Unit&, int, int, int, int, int) const {}
    __device__ __forceinline__ void operator()(const f32x4 (&acc)[2][2][4][2], const Unit& u, int wr, int wc, int fr, int fq) const {
        const int row0 = u.pm * BM + wr * 64 + fr; const int col0 = u.pn * BM + wc * 32 + 8 * fq;
        f32x4 bv[2][2];
#pragma unroll
        for (int bj = 0; bj < 2; ++bj)
#pragma unroll
            for (int n = 0; n < 2; ++n) bv[bj][n] = (ACT == 2) ? *(const f32x4*)(bias + col0 + bj * HALF + 4 * n) : (f32x4){0.f, 0.f, 0.f, 0.f};
#pragma unroll
        for (int ai = 0; ai < 2; ++ai)
#pragma unroll
            for (int m = 0; m < 4; ++m) { bf16_t* rowp = O + (size_t)(row0 + ai * HALF + m * 16) * ldc + col0;
#pragma unroll
                for (int bj = 0; bj < 2; ++bj) { f32x4 v0 = acc[ai][bj][m][0] + bv[bj][0], v1 = acc[ai][bj][m][1] + bv[bj][1];
                    if (ACT == 2) {
#pragma unroll
                        for (int j = 0; j < 4; ++j) { v0[j] = fmaxf(sigm(v0[j]), 1e-12f); v1[j] = fmaxf(sigm(v1[j]), 1e-12f); } }
                    u32x4 w; w.x = cvt_pk_bf16(v0[0], v0[1]); w.y = cvt_pk_bf16(v0[2], v0[3]); w.z = cvt_pk_bf16(v1[0], v1[1]); w.w = cvt_pk_bf16(v1[2], v1[3]);
                    *(u32x4*)(rowp + bj * HALF) = w; } }
    }
};
struct EpiSwiGLU {
    static constexpr bool PERM = true, AFTER_DRAIN = false, HORNER = false;
    bf16_t* O; int ldc;
    __device__ __forceinline__ void mid(f32x4 (&)[2][2][4][2], const Unit&, int, int, int, int, int) const {}
    __device__ __forceinline__ void operator()(const f32x4 (&acc)[2][2][4][2], const Unit& u, int wr, int wc, int fr, int fq) const {
        const int row0 = u.pm * BM + wr * 64 + fr; const int col0 = u.pn * HALF + wc * 32 + 8 * fq;
#pragma unroll
        for (int ai = 0; ai < 2; ++ai)
#pragma unroll
            for (int m = 0; m < 4; ++m) { bf16_t* rowp = O + (size_t)(row0 + ai * HALF + m * 16) * ldc + col0;
                f32x4 g0 = acc[ai][0][m][0], g1 = acc[ai][0][m][1]; const f32x4 u0 = acc[ai][1][m][0], u1 = acc[ai][1][m][1];
#pragma unroll
                for (int j = 0; j < 4; ++j) { g0[j] = g0[j] * sigm(g0[j]) * u0[j]; g1[j] = g1[j] * sigm(g1[j]) * u1[j]; }
                u32x4 w; w.x = cvt_pk_bf16(g0[0], g0[1]); w.y = cvt_pk_bf16(g0[2], g0[3]); w.z = cvt_pk_bf16(g1[0], g1[1]); w.w = cvt_pk_bf16(g1[2], g1[3]);
                *(u32x4*)rowp = w; }
    }
};
struct EpiF32 {
    static constexpr bool PERM = false, AFTER_DRAIN = false, HORNER = false;
    float* C; int ldc;
    __device__ __forceinline__ void mid(f32x4 (&)[2][2][4][2], const Unit&, int, int, int, int, int) const {}
    __device__ __forceinline__ void operator()(const f32x4 (&acc)[2][2][4][2], const Unit& u, int wr, int wc, int fr, int fq) const {
        const int row0 = u.pm * BM + wr * 64 + fr, col0 = u.pn * BM + wc * 32 + 4 * fq;
#pragma unroll
        for (int ai = 0; ai < 2; ++ai)
#pragma unroll
            for (int m = 0; m < 4; ++m) { float* rowp = C + (size_t)(row0 + ai * HALF + m * 16) * ldc + col0;
#pragma unroll
                for (int bj = 0; bj < 2; ++bj)
#pragma unroll
                    for (int n = 0; n < 2; ++n) *(f32x4*)(rowp + bj * HALF + n * 16) = acc[ai][bj][m][n]; }
    }
};
struct EpiHorner {
    static constexpr bool PERM = true, AFTER_DRAIN = false, HORNER = true;
    bf16_t* O; int ldc; const bf16_t* G;
    __device__ __forceinline__ void mid(f32x4 (&acc)[2][2][4][2], const Unit& u, int t, int wr, int wc, int fr, int fq) const {
        const __amdgpu_buffer_rsrc_t rs = __builtin_amdgcn_make_buffer_rsrc((void*)G, 0, (int)(17408u * 12288u * 2u), 0x00020000);
        const unsigned vo = (unsigned)((wr * 64 + fr) * 12288 + wc * 32 + 8 * fq) * 2u;
        const unsigned so0 = (unsigned)__builtin_amdgcn_readfirstlane((u.pm * BM * 12288 + u.pn * BM + ((t == 32) ? 0 : 4096)) * 2);
#pragma unroll
        for (int ai = 0; ai < 2; ++ai)
#pragma unroll
            for (int m = 0; m < 4; ++m)
#pragma unroll
                for (int bj = 0; bj < 2; ++bj) { const unsigned so = so0 + (unsigned)(((ai * HALF + m * 16) * 12288 + bj * HALF) * 2);
                    const u32x4 a = __builtin_amdgcn_raw_buffer_load_b128(rs, vo, so, 0), b = __builtin_amdgcn_raw_buffer_load_b128(rs, vo, so + 8192u, 0);
                    const f32x4 a0 = bf4lo(a.x, a.y), a1 = bf4lo(a.z, a.w), b0 = bf4lo(b.x, b.y), b1 = bf4lo(b.z, b.w);
#pragma unroll
                    for (int j = 0; j < 4; ++j) { acc[ai][bj][m][0][j] *= a0[j] * __builtin_amdgcn_rcpf(b0[j]); acc[ai][bj][m][1][j] *= a1[j] * __builtin_amdgcn_rcpf(b1[j]); }
                    if (bj) asm volatile("" ::: "memory"); }
    }
    __device__ __forceinline__ void operator()(const f32x4 (&acc)[2][2][4][2], const Unit& u, int wr, int wc, int fr, int fq) const {
        const __amdgpu_buffer_rsrc_t rs = __builtin_amdgcn_make_buffer_rsrc((void*)G, 0, (int)(17408u * 12288u * 2u), 0x00020000);
        const unsigned vo = (unsigned)((wr * 64 + fr) * 12288 + wc * 32 + 8 * fq) * 2u;
        const unsigned so0 = (unsigned)__builtin_amdgcn_readfirstlane((u.pm * BM * 12288 + u.pn * BM + 8192) * 2);
        const int row0 = u.pm * BM + wr * 64 + fr; const int col0 = u.pn * BM + wc * 32 + 8 * fq;
#pragma unroll
        for (int ai = 0; ai < 2; ++ai)
#pragma unroll
            for (int m = 0; m < 4; ++m) { bf16_t* rowp = O + (size_t)(row0 + ai * HALF + m * 16) * ldc + col0;
#pragma unroll
                for (int bj = 0; bj < 2; ++bj) { const unsigned so = so0 + (unsigned)(((ai * HALF + m * 16) * 12288 + bj * HALF) * 2);
                    const u32x4 c = __builtin_amdgcn_raw_buffer_load_b128(rs, vo, so, 0); const f32x4 v0 = acc[ai][bj][m][0] * bf4lo(c.x, c.y), v1 = acc[ai][bj][m][1] * bf4lo(c.z, c.w);
                    u32x4 w; w.x = cvt_pk_bf16(v0[0], v0[1]); w.y = cvt_pk_bf16(v0[2], v0[3]); w.z = cvt_pk_bf16(v1[0], v1[1]); w.w = cvt_pk_bf16(v1[2], v1[3]);
                    *(u32x4*)(rowp + bj * HALF) = w; }
                asm volatile("" ::: "memory"); }
    }
};

template <class Epi, class Sched, bool ALIGN_EPI = true, bool SP2 = true>
__device__ __forceinline__ void gemm_phase(PG8_LAS unsigned char* lds, const Gemm g, const Sched& S, const Epi& E) {
    const int tid = opaque_tid(), wid = __builtin_amdgcn_readfirstlane(tid >> 6), lane = tid & 63, wr = wid >> 2, wc = wid & 3, fr = lane & 15, fq = lane >> 4;
    const int K = g.K, nt = K / BK;
    unsigned voffA[2], voffB[2];
#pragma unroll
    for (int i = 0; i < 2; ++i) { int R, C; stage_rc(tid * 16 + i * 8192, R, C); const int Rb = Epi::PERM ? ((R & ~31) + perm32(R & 31)) : R;
        voffA[i] = (unsigned)(R * g.lda + C) * 2u; voffB[i] = (unsigned)(Rb * K + C) * 2u; }
    const size_t kstep = (size_t)(BK * 2);
    const size_t hstepB = (size_t)HALF * K * 2, hstepA = (size_t)HALF * g.lda * 2;
    const size_t tstepB = 2 * hstepB, tstepA = 2 * hstepA;
    const unsigned ldsw = (unsigned)wid * 1024u;
    const int aoff = lds_byte(wr * 64 + fr, fq * 8), boff = lds_byte(wc * 32 + fr, fq * 8);
#define PG8_SA(b, h) (((b) * 2 + (h)) * HTB)
#define PG8_SB(b, h) ((4 + (b) * 2 + (h)) * HTB)
#define PG8_STAGE(bufoff, gbase, voff) do { _Pragma("unroll") for (int _i = 0; _i < 2; ++_i) \
        __builtin_amdgcn_global_load_lds((const unsigned*)((const char*)(gbase) + (voff)[_i]), (PG8_LAS unsigned*)(lds + (bufoff) + ldsw + _i * 8192), 16, 0, 0); } while (0)
#define PG8_LDA(dst, b, h) do { _Pragma("unroll") for (int m = 0; m < 4; ++m) _Pragma("unroll") for (int k = 0; k < 2; ++k) dst[m][k] = *(const PG8_LAS bf16x8*)(lds + PG8_SA(b, h) + aoff + m * 2048 + k * 1024); } while (0)
#define PG8_LDB(dst, b, h) do { _Pragma("unroll") for (int n = 0; n < 2; ++n) _Pragma("unroll") for (int k = 0; k < 2; ++k) dst[n][k] = *(const PG8_LAS bf16x8*)(lds + PG8_SB(b, h) + boff + n * 2048 + k * 1024); } while (0)
#define PG8_MMA(ai, bj, At, Bt) do { __builtin_amdgcn_s_setprio(1); _Pragma("unroll") for (int m = 0; m < 4; ++m) _Pragma("unroll") for (int n = 0; n < 2; ++n) _Pragma("unroll") for (int k = 0; k < 2; ++k) \
        acc[ai][bj][m][n] = __builtin_amdgcn_mfma_f32_16x16x32_bf16(Bt[n][k], At[m][k], acc[ai][bj][m][n], 0, 0, 0); __builtin_amdgcn_s_setprio(0); } while (0)
#define PG8_WAIT_V(n) asm volatile("s_waitcnt vmcnt(" #n ")" ::: "memory")
#define PG8_WAIT_L(n) asm volatile("s_waitcnt lgkmcnt(" #n ")" ::: "memory")
#define PG8_BAR __builtin_amdgcn_s_barrier()
#define PG8_SCHED __builtin_amdgcn_sched_barrier(0)
    Unit cur, nxt; int ui = 0;
    if (!S.next(0, cur)) return;
    f32x4 acc[2][2][4][2];
#pragma unroll
    for (int a = 0; a < 2; ++a)
#pragma unroll
        for (int b = 0; b < 2; ++b)
#pragma unroll
            for (int m = 0; m < 4; ++m)
#pragma unroll
                for (int n = 0; n < 2; ++n) acc[a][b][m][n] = (f32x4){0.f, 0.f, 0.f, 0.f};
    bf16x8 At[4][2], B0[2][2], B1[2][2];
    const char* cA = (const char*)g.A + (size_t)cur.pm * tstepA; const char* cB = (const char*)g.Bt + (size_t)cur.pn * tstepB;
    S.a_ready(cur);
    if constexpr (SP2) {
        PG8_STAGE(PG8_SB(0, 0), cB, voffB); PG8_STAGE(PG8_SB(0, 1), cB + hstepB, voffB); PG8_STAGE(PG8_SA(0, 0), cA, voffA); PG8_STAGE(PG8_SA(0, 1), cA + hstepA, voffA);
        if (wr == 1) PG8_BAR;
        PG8_WAIT_V(2); PG8_BAR;
        PG8_STAGE(PG8_SB(1, 0), cB + kstep, voffB); PG8_STAGE(PG8_SA(1, 0), cA + kstep, voffA); PG8_STAGE(PG8_SB(1, 1), cB + hstepB + kstep, voffB);
        PG8_WAIT_V(6); PG8_BAR;
    } else {
        PG8_STAGE(PG8_SB(0, 0), cB, voffB); PG8_STAGE(PG8_SA(0, 0), cA, voffA); PG8_STAGE(PG8_SB(0, 1), cB + hstepB, voffB); PG8_STAGE(PG8_SA(0, 1), cA + hstepA, voffA);
        if (wr == 1) PG8_BAR;
        PG8_WAIT_V(4); PG8_BAR;
        PG8_STAGE(PG8_SB(1, 0), cB + kstep, voffB); PG8_STAGE(PG8_SA(1, 0), cA + kstep, voffA); PG8_STAGE(PG8_SB(1, 1), cB + hstepB + kstep, voffB);
        PG8_WAIT_V(6); PG8_BAR;
    }
    for (;;) {
        const bool has_next = S.next(ui + 1, nxt);
        const char* nA = has_next ? (const char*)g.A + (size_t)nxt.pm * tstepA : cA; const char* nB = has_next ? (const char*)g.Bt + (size_t)nxt.pn * tstepB : cB;
        for (int t = 0; t < nt; t += 2) {
            const bool last = (t == nt - 2);
            const char* a1 = cA + (size_t)(t + 1) * kstep;
            const char* a2 = last ? nA : cA + (size_t)(t + 2) * kstep; const char* b2 = last ? nB : cB + (size_t)(t + 2) * kstep;
            const char* a3 = a2 + kstep; const char* b3 = b2 + kstep;
            if constexpr (Epi::HORNER) { if (t == 32 || t == 48) E.mid(acc, cur, t, wr, wc, fr, fq); }
            if (last && has_next) S.a_ready(nxt);
            if constexpr (SP2) {
            PG8_LDB(B0, 0, 0); PG8_LDB(B1, 0, 1); PG8_SCHED; PG8_LDA(At, 0, 0); PG8_STAGE(PG8_SA(1, 1), a1 + hstepA, voffA);
            PG8_WAIT_V(8); PG8_WAIT_L(0); PG8_BAR; PG8_MMA(0, 0, At, B0); PG8_MMA(0, 1, At, B1); PG8_BAR; PG8_SCHED;
            PG8_LDA(At, 0, 1); PG8_STAGE(PG8_SB(0, 0), b2, voffB); PG8_STAGE(PG8_SB(0, 1), b2 + hstepB, voffB); PG8_STAGE(PG8_SA(0, 0), a2, voffA);
            PG8_WAIT_V(8); PG8_WAIT_L(0); PG8_BAR; PG8_MMA(1, 0, At, B0); PG8_MMA(1, 1, At, B1); PG8_BAR; PG8_SCHED;
            PG8_LDB(B0, 1, 0); PG8_LDB(B1, 1, 1); PG8_SCHED; PG8_LDA(At, 1, 0); PG8_STAGE(PG8_SA(0, 1), a2 + hstepA, voffA);
            PG8_WAIT_V(8); PG8_WAIT_L(0); PG8_BAR; PG8_MMA(0, 0, At, B0); PG8_MMA(0, 1, At, B1); PG8_BAR; PG8_SCHED;
            PG8_LDA(At, 1, 1); PG8_STAGE(PG8_SB(1, 0), b3, voffB); PG8_STAGE(PG8_SB(1, 1), b3 + hstepB, voffB); PG8_STAGE(PG8_SA(1, 0), a3, voffA);
            PG8_WAIT_V(8); PG8_WAIT_L(0); PG8_BAR; PG8_MMA(1, 0, At, B0); PG8_MMA(1, 1, At, B1); PG8_BAR; PG8_SCHED;
            } else {
            PG8_LDB(B0, 0, 0); PG8_SCHED; PG8_LDA(At, 0, 0); PG8_STAGE(PG8_SA(1, 1), a1 + hstepA, voffA);
            PG8_WAIT_L(8); PG8_BAR; PG8_WAIT_L(0); PG8_MMA(0, 0, At, B0); PG8_BAR; PG8_SCHED;
            PG8_LDB(B1, 0, 1); PG8_STAGE(PG8_SB(0, 0), b2, voffB);
            PG8_BAR; PG8_WAIT_L(0); PG8_MMA(0, 1, At, B1); PG8_BAR;
            PG8_LDA(At, 0, 1); PG8_STAGE(PG8_SA(0, 0), a2, voffA);
            PG8_BAR; PG8_WAIT_L(0); PG8_MMA(1, 0, At, B0); PG8_BAR; PG8_SCHED;
            PG8_STAGE(PG8_SB(0, 1), b2 + hstepB, voffB);
            PG8_WAIT_V(6); PG8_BAR; PG8_MMA(1, 1, At, B1); PG8_BAR;
            PG8_LDB(B0, 1, 0); PG8_SCHED; PG8_LDA(At, 1, 0); PG8_STAGE(PG8_SA(0, 1), a2 + hstepA, voffA);
            PG8_WAIT_L(8); PG8_BAR; PG8_WAIT_L(0); PG8_MMA(0, 0, At, B0); PG8_BAR; PG8_SCHED;
            PG8_LDB(B1, 1, 1); PG8_STAGE(PG8_SB(1, 0), b3, voffB);
            PG8_BAR; PG8_WAIT_L(0); PG8_MMA(0, 1, At, B1); PG8_BAR;
            PG8_LDA(At, 1, 1); PG8_STAGE(PG8_SA(1, 0), a3, voffA);
            PG8_BAR; PG8_WAIT_L(0); PG8_MMA(1, 0, At, B0); PG8_BAR; PG8_SCHED;
            PG8_STAGE(PG8_SB(1, 1), b3 + hstepB, voffB);
            PG8_WAIT_V(6); PG8_BAR; PG8_MMA(1, 1, At, B1); PG8_BAR;
            }
        }
        if constexpr (ALIGN_EPI) { if (wr == 0) PG8_BAR; }
        E(acc, cur, wr, wc, fr, fq); S.done(cur);
        if (!has_next) break;
#pragma unroll
        for (int a = 0; a < 2; ++a)
#pragma unroll
            for (int b = 0; b < 2; ++b)
#pragma unroll
                for (int m = 0; m < 4; ++m)
#pragma unroll
                    for (int n = 0; n < 2; ++n) acc[a][b][m][n] = (f32x4){0.f, 0.f, 0.f, 0.f};
        cur = nxt; cA = nA; cB = nB; ++ui;
        if constexpr (ALIGN_EPI) { if (wr == 1) PG8_BAR; }
    }
    PG8_WAIT_V(0);
    if constexpr (!ALIGN_EPI) { if (wr == 0) PG8_BAR; }
    PG8_BAR;
#undef PG8_SA
#undef PG8_SB
#undef PG8_STAGE
#undef PG8_LDA
#undef PG8_LDB
#undef PG8_MMA
#undef PG8_WAIT_V
#undef PG8_WAIT_L
#undef PG8_BAR
#undef PG8_SCHED
}
}

constexpr int D = 4096, NB = 4, SEQ = 4096, DEPTH = 4, GRIDW = 64, CTXL = 256, HD = 128;
constexpr int TPB = CTXL + SEQ;
constexpr int M = NB * TPB;
constexpr int INW = 9728, DFF = 11008, GRK = 512, ADAR = 256;
constexpr int C_AQ = 0, C_AK = 2048, C_AV = 2560, C_BQ = 3072, C_BK = 4096, C_BV = 5120, C_CQ = 6144, C_CK = 7168, C_CV = 8192, C_GL = 9216;
constexpr float EPS = 1e-6f;

constexpr size_t MiB = 1u << 20;
constexpr size_t WS_CTL = 0, CTL_ZERO_BYTES = 1 * MiB;
constexpr size_t WS_T1P = 1 * MiB;
constexpr size_t WS_MOD = 2 * MiB;
constexpr size_t WS_ROPE = 4 * MiB;
constexpr size_t WS_LAM = 4 * MiB + 65536;
constexpr size_t WS_BMASK = 5 * MiB;
constexpr size_t WS_BIAS = 6 * MiB;
constexpr size_t WS_W = 16 * MiB;
constexpr size_t W_IN = 0, W_GATE = W_IN + (size_t)INW * D * 2, W_BR = W_GATE + (size_t)3 * D * GRK * 2, W_OUT = W_BR + (size_t)D * D * 2,
                 W_FFI = W_OUT + (size_t)D * D * 2, W_FFO = W_FFI + (size_t)2 * DFF * D * 2, W_LAYER = W_FFO + (size_t)D * DFF * 2;
constexpr size_t WS_X = 1664 * MiB;
constexpr size_t WS_H = 1936 * MiB;
constexpr size_t WS_PROJ = 2072 * MiB;
constexpr size_t WS_MIX = 2395 * MiB;
constexpr size_t WS_G = 2531 * MiB;
constexpr size_t WS_MRG = 2939 * MiB;
constexpr size_t WS_Y = 3075 * MiB;
constexpr size_t WS_ACT = 3347 * MiB;
constexpr size_t WS_END = 3713 * MiB;
static_assert(WS_W + DEPTH * W_LAYER <= WS_X && WS_X + (size_t)M * D * 4 <= WS_H && WS_H + (size_t)M * D * 2 <= WS_PROJ && WS_PROJ + (size_t)M * INW * 2 <= WS_MIX &&
              WS_MIX + (size_t)M * D * 2 <= WS_G && WS_G + (size_t)M * 3 * D * 2 <= WS_MRG && WS_MRG + (size_t)M * D * 2 <= WS_Y && WS_Y + (size_t)M * D * 4 <= WS_ACT &&
              WS_ACT + (size_t)M * DFF * 2 <= WS_END && WS_BIAS + (size_t)4 * 8 * 15 * 2 * 2048 * 4 <= WS_W, "d_ws map");
constexpr int CW_BAR = 4096;

constexpr int RING_BYTES = 139264;
constexpr int MISC_OFF = RING_BYTES;
constexpr int LDS_BYTES = 147456;
static_assert(MISC_OFF + 256 <= LDS_BYTES, "LDS map");

#define GAS __attribute__((address_space(1)))
#define LAS __attribute__((address_space(3)))
typedef unsigned short bf16;
typedef unsigned v4u __attribute__((ext_vector_type(4)));
typedef unsigned v2u __attribute__((ext_vector_type(2)));
typedef float f32x4 __attribute__((ext_vector_type(4)));
typedef short bf16x8 __attribute__((ext_vector_type(8)));
typedef short s16x4 __attribute__((ext_vector_type(4)));
typedef float f32x16 __attribute__((ext_vector_type(16)));
#define RLX_AGENT __ATOMIC_RELAXED, __HIP_MEMORY_SCOPE_AGENT
__device__ __forceinline__ unsigned f2bf(float f) { unsigned u = __builtin_bit_cast(unsigned, f); return (u + 0x7fffu + ((u >> 16) & 1u)) >> 16; }
__device__ __forceinline__ unsigned pk2(float lo, float hi) { return pg8::cvt_pk_bf16(lo, hi); }
__device__ __forceinline__ float bflo(unsigned w) { return __uint_as_float(w << 16); }
__device__ __forceinline__ float bfhi(unsigned w) { return __uint_as_float(w & 0xffff0000u); }
__device__ __forceinline__ float wave_sum(float v) {
#pragma unroll
    for (int o = 1; o < 64; o <<= 1) v += __shfl_xor(v, o);
    return v;
}

#define XB_TMO      128
#define XB_XCNT(j)  (256  + 64 * (j))
#define XB_XSUB(j)  (1280 + 64 * (j))
#define XB_XGEN(j)  (2304 + 64 * (j))
#define XB_TOP      3328
#define XB_TOPGEN   3392
#define XCD_BAR_WORDS 3456
#define XB_SPIN_CAP (1u << 22)
__device__ __forceinline__ unsigned xb_ld(unsigned* p)              { return __hip_atomic_load(p, __ATOMIC_RELAXED, __HIP_MEMORY_SCOPE_AGENT); }
__device__ __forceinline__ unsigned xb_add(unsigned* p, unsigned v) { return __hip_atomic_fetch_add(p, v, __ATOMIC_RELAXED, __HIP_MEMORY_SCOPE_AGENT); }
__device__ __forceinline__ unsigned xb_xcc_id() { return (unsigned)__builtin_amdgcn_s_getreg((3 << 11) | 20) & 0xFu; }
#define XB_SPIN(cond, bar) do { unsigned _sp = 0; while (cond) { __builtin_amdgcn_s_sleep(1); \
    if ((++_sp & 255u) == 0u) { if (xb_ld(&(bar)[XB_TMO])) break; if (_sp > XB_SPIN_CAP) { atomicAdd(&(bar)[XB_TMO], 1u); break; } } } } while (0)
struct XcdBarrier { unsigned* bar; unsigned x; volatile LAS unsigned* st; };
__device__ __forceinline__ XcdBarrier xcd_barrier_post(unsigned* bar, volatile LAS unsigned* st) {
    XcdBarrier b; b.bar = bar; b.x = xb_xcc_id(); b.st = st;
    if (threadIdx.x == 0) (void)xb_add(&bar[XB_XCNT(b.x)], 1u);
    return b;
}
__device__ __forceinline__ void xcd_barrier_complete(unsigned* bar, unsigned x, unsigned& nloc, unsigned& nx) {
    const unsigned G = gridDim.x * gridDim.y * gridDim.z;
    unsigned sum, cnt, mine, sp = 0u;
    for (;;) {
        sum = 0u; cnt = 0u; mine = 0u;
#pragma unroll
        for (unsigned j = 0; j < 16; ++j) { const unsigned c = xb_ld(&bar[XB_XCNT(j)]); sum += c; cnt += (c > 0u) ? 1u : 0u; mine = (j == x) ? c : mine; }
        if (sum == G) break;
        __builtin_amdgcn_s_sleep(1);
        if ((++sp & 255u) == 0u) { if (xb_ld(&bar[XB_TMO])) break; if (sp > XB_SPIN_CAP) { atomicAdd(&bar[XB_TMO], 1u); break; } }
    }
    nloc = mine > 0u ? mine : 1u; nx = cnt > 0u ? cnt : 1u;
}
__device__ __forceinline__ void xcd_barrier(const XcdBarrier& b) {
    asm volatile("s_waitcnt vmcnt(0)" ::: "memory");
    __syncthreads();
    if (threadIdx.x == 0) {
        unsigned* bar = b.bar;
        __builtin_amdgcn_s_waitcnt(0);
        unsigned nloc = b.st[0], nx = b.st[1];
        if (nloc == 0u) { xcd_barrier_complete(bar, b.x, nloc, nx); b.st[0] = nloc; b.st[1] = nx; }
        const unsigned old = xb_add(&bar[XB_XSUB(b.x)], 1u);
        const unsigned gen = old / nloc;
        if (old + 1u == (gen + 1u) * nloc) {
            __builtin_amdgcn_fence(__ATOMIC_RELEASE, "agent");
            asm volatile("s_waitcnt vmcnt(0)" ::: "memory");
            const unsigned og = xb_add(&bar[XB_TOP], 1u);
            const unsigned tg = og / nx;
            if (og + 1u == (tg + 1u) * nx) xb_add(&bar[XB_TOPGEN], 1u);
            else XB_SPIN(xb_ld(&bar[XB_TOPGEN]) == tg, bar);
            __builtin_amdgcn_fence(__ATOMIC_ACQUIRE, "agent");
            xb_add(&bar[XB_XGEN(b.x)], 1u);
            asm volatile("s_waitcnt vmcnt(0)" ::: "memory");
        } else {
            XB_SPIN(xb_ld(&bar[XB_XGEN(b.x)]) == gen, bar);
            __builtin_amdgcn_fence(__ATOMIC_ACQUIRE, "agent");
            asm volatile("s_waitcnt vmcnt(0)" ::: "memory");
        }
    }
    __syncthreads();
}

namespace att {
constexpr int KVBLK = 64, LDQ = INW, LDK = INW;
constexpr int SHM_V = KVBLK * 128 * 2, SHM_K = KVBLK * 128 * 2, WS_OFF = 2 * SHM_V + 2 * SHM_K, OST_OFF = WS_OFF + 8 * 64 * 4, OST_STRIDE = 272, OST_WAVE = 32 * OST_STRIDE, LDS_NEED = OST_OFF + 8 * OST_WAVE;
static_assert(LDS_NEED <= RING_BYTES, "attention LDS");
#define KSWZ(row, colB) ((row) * 256 + ((colB) ^ (((row) & 7) << 4)))
#define SBAR() __builtin_amdgcn_sched_barrier(0)
__device__ __forceinline__ int crow(int r, int hi) { return (r & 3) + 8 * (r >> 2) + 4 * hi; }
__device__ __forceinline__ unsigned cvtpk(float lo, float hi) { unsigned r; asm volatile("v_cvt_pk_bf16_f32 %0, %1, %2" : "=v"(r) : "v"(lo), "v"(hi)); return r; }
constexpr float THR = 8.f;
template <int MODE> struct Cfg { static constexpr float SCALE = (MODE == 1) ? 0.125f : 0.088388347648318440f; static constexpr int ND0 = (MODE == 1) ? 4 : 8; };

template <int MODE> __device__ __forceinline__ void partialSM(f32x16& p0, f32x16& p1, float& m_reg, float& mn, float& alpha) {
  constexpr float SC = Cfg<MODE>::SCALE, C = SC * 1.4426950408889634f;
  float pmax = p0[0]; for (int r = 1; r < 16; ++r) pmax = fmaxf(pmax, p0[r]); for (int r = 0; r < 16; ++r) pmax = fmaxf(pmax, p1[r]);
  { auto rr = __builtin_amdgcn_permlane32_swap(__float_as_uint(pmax), __float_as_uint(pmax), false, false);
    pmax = fmaxf(__uint_as_float(rr[0]), __uint_as_float(rr[1])); }
  if (__builtin_expect(__all(pmax - m_reg <= THR / SC), 1)) { mn = m_reg; alpha = 1.f; }
  else { mn = fmaxf(m_reg, pmax); alpha = __builtin_amdgcn_exp2f((m_reg - mn) * C); m_reg = mn; }
  float mnC = -mn * C;
  for (int r = 0; r < 16; ++r) p0[r] = fmaf(p0[r], C, mnC); for (int r = 0; r < 16; ++r) p1[r] = fmaf(p1[r], C, mnC);
  for (int r = 0; r < 16; ++r) p0[r] = __builtin_amdgcn_exp2f(p0[r]);
}
__device__ __forceinline__ void finishSM(f32x16& p0, f32x16& p1, float alpha, float& l_reg, bf16x8& pa0, bf16x8& pa1, bf16x8& pa2, bf16x8& pa3) {
  for (int r = 0; r < 16; ++r) p1[r] = __builtin_amdgcn_exp2f(p1[r]);
  float ps = 0; for (int r = 0; r < 16; ++r) ps += p0[r]; for (int r = 0; r < 16; ++r) ps += p1[r];
  { auto rr = __builtin_amdgcn_permlane32_swap(__float_as_uint(ps), __float_as_uint(ps), false, false);
    ps = __uint_as_float(rr[0]) + __uint_as_float(rr[1]); }
  l_reg = l_reg * alpha + ps;
#define PK4(P, BASE, OUT) do { unsigned a0 = cvtpk(P[BASE + 0], P[BASE + 1]), a1 = cvtpk(P[BASE + 2], P[BASE + 3]);   \
    unsigned b0 = cvtpk(P[BASE + 4], P[BASE + 5]), b1 = cvtpk(P[BASE + 6], P[BASE + 7]);                              \
    auto r0 = __builtin_amdgcn_permlane32_swap(a0, b0, false, false); auto r1 = __builtin_amdgcn_permlane32_swap(a1, b1, false, false); \
    v4u w = {r0[0], r1[0], r0[1], r1[1]}; OUT = *reinterpret_cast<bf16x8*>(&w); } while (0)
  PK4(p0, 0, pa0); PK4(p0, 8, pa1); PK4(p1, 0, pa2); PK4(p1, 8, pa3);
#undef PK4
}
template <int MODE> __device__ __forceinline__ void qkt(f32x16& p0, f32x16& p1, const char* Ks, const bf16x8* qr, int r32, int hi, const float* bias, int lane) {
  if constexpr (MODE == 2) {
    const f32x4* bp = (const f32x4*)bias + lane;
#pragma unroll
    for (int g = 0; g < 4; ++g) { const f32x4 a = bp[g * 64], b = bp[(4 + g) * 64];
#pragma unroll
      for (int j = 0; j < 4; ++j) { p0[4 * g + j] = a[j]; p1[4 * g + j] = b[j]; } }
  } else { p0 = f32x16{}; p1 = f32x16{}; }
#pragma unroll
  for (int d0 = 0; d0 < Cfg<MODE>::ND0; ++d0) { int cb = (d0 * 16 + hi * 8) * 2;
    bf16x8 b0 = *reinterpret_cast<const bf16x8*>(Ks + KSWZ(r32, cb));
    bf16x8 b1 = *reinterpret_cast<const bf16x8*>(Ks + KSWZ(32 + r32, cb));
    p0 = __builtin_amdgcn_mfma_f32_32x32x16_bf16(b0, qr[d0], p0, 0, 0, 0);
    p1 = __builtin_amdgcn_mfma_f32_32x32x16_bf16(b1, qr[d0], p1, 0, 0, 0); }
}
__device__ __forceinline__ int v_st(int k, int c) { const int kk = (k & ~0xC) | ((k & 4) << 1) | ((k & 8) >> 1); return ((kk >> 3) * 4 + (c >> 5)) * 512 + ((kk & 7) * 32 + (c & 31)) * 2; }
__device__ __forceinline__ int v_rd_base(int lane) { return ((lane & 3) << 3) | (((lane >> 2) & 3) << 6) | (((lane >> 4) & 1) << 5) | (((lane >> 5) & 1) << 8); }
constexpr int v_rd_off(int d0, int ks, int half) { return d0 * 512 + ks * 4096 + half * 2048; }
template <int OFF> __device__ __forceinline__ s16x4 tr_read(int vb) {
  s16x4 r; asm volatile("ds_read_b64_tr_b16 %0, %1 offset:%2" : "=&v"(r) : "v"(vb), "i"(OFF) : "memory"); return r;
}
template <int D0> __device__ __forceinline__ void pv_one(f32x16& od, int vb, bf16x8 pa0, bf16x8 pa1, bf16x8 pa2, bf16x8 pa3) {
  const s16x4 l0 = tr_read<v_rd_off(D0, 0, 0)>(vb), h0 = tr_read<v_rd_off(D0, 0, 1)>(vb), l1 = tr_read<v_rd_off(D0, 1, 0)>(vb), h1 = tr_read<v_rd_off(D0, 1, 1)>(vb);
  const s16x4 l2 = tr_read<v_rd_off(D0, 2, 0)>(vb), h2 = tr_read<v_rd_off(D0, 2, 1)>(vb), l3 = tr_read<v_rd_off(D0, 3, 0)>(vb), h3 = tr_read<v_rd_off(D0, 3, 1)>(vb);
  asm volatile("s_waitcnt lgkmcnt(0)" ::: "memory"); SBAR();
#define PK(L, H) (bf16x8){L[0], L[1], L[2], L[3], H[0], H[1], H[2], H[3]}
  od = __builtin_amdgcn_mfma_f32_32x32x16_bf16(pa0, PK(l0, h0), od, 0, 0, 0);
  od = __builtin_amdgcn_mfma_f32_32x32x16_bf16(pa1, PK(l1, h1), od, 0, 0, 0);
  od = __builtin_amdgcn_mfma_f32_32x32x16_bf16(pa2, PK(l2, h2), od, 0, 0, 0);
  od = __builtin_amdgcn_mfma_f32_32x32x16_bf16(pa3, PK(l3, h3), od, 0, 0, 0);
#undef PK
}
__device__ __forceinline__ void pv_d0(f32x16* o, int vb, bf16x8 pa0, bf16x8 pa1, bf16x8 pa2, bf16x8 pa3) {
  pv_one<0>(o[0], vb, pa0, pa1, pa2, pa3); pv_one<1>(o[1], vb, pa0, pa1, pa2, pa3); pv_one<2>(o[2], vb, pa0, pa1, pa2, pa3); pv_one<3>(o[3], vb, pa0, pa1, pa2, pa3);
}

struct Tiles {
  int NT;
  int jmax;
  int jsplit, extra;
  const float* btab;
  const float* bmask; const float* bzero;
  int rlo, nrows, Rw, r0w, half;
  __device__ __forceinline__ int krow(int j) const { const int je = j < jmax ? j : jmax; return je * 64 + (je >= jsplit ? extra : 0); }
  __device__ __forceinline__ const float* bias(int j) const {
    if (j < 4) return bzero;
    const int i = j - 4, rr = rlo + i; const bool in = (i < nrows) && (rr >= r0w) && (rr < r0w + 8);
    return in ? btab + (size_t)((rr - Rw + 7) * 2 + half) * 2048 : bmask;
  }
};

template <int MODE>
__device__ __forceinline__ void attn_core(const bf16* Pb, unsigned qoff, unsigned koff, unsigned voff, const Tiles& T, int kcolB, char* lds, f32x16 (&o)[4]) {
  const int tid = opaque_tid(), wid = __builtin_amdgcn_readfirstlane(tid >> 6), lane = tid & 63, r32 = lane & 31, hi = lane >> 5;
  char* V_lds = lds; char* K_lds = lds + 2 * SHM_V;
  float* ws = (float*)(lds + WS_OFF) + wid * 64; float* li_l = ws; float* al_l = ws + 32;
  float m_reg = -1e30f, l_reg = 0; bf16x8 qr[Cfg<MODE>::ND0];
#pragma unroll
  for (int d = 0; d < 4; ++d) o[d] = f32x16{};
  const __amdgpu_buffer_rsrc_t rsrc = __builtin_amdgcn_make_buffer_rsrc((void*)Pb, 0, (int)((size_t)M * INW * 2), 0x00020000);
  { const unsigned qv = (unsigned)((wid * 32 + r32) * LDQ + hi * 8) * 2u, qs = __builtin_amdgcn_readfirstlane(qoff * 2u);
#pragma unroll
    for (int d0 = 0; d0 < Cfg<MODE>::ND0; ++d0) { const v4u w = __builtin_amdgcn_raw_buffer_load_b128(rsrc, qv + d0 * 32, qs, 0); qr[d0] = *reinterpret_cast<const bf16x8*>(&w); } }
  const int sr = tid >> 4, sc = (tid & 15) * 8, vst0 = v_st(sr, sc), vst1 = v_st(32 + sr, sc);
  const unsigned kvv = (unsigned)(sr * LDK + sc) * 2u;
  const int vb0 = (int)(uintptr_t)V_lds + v_rd_base(lane);
  struct { bf16x8 vs0, vs1, ks0, ks1; } sr_[2];
#define SLOAD(i, j) do { const unsigned k0_ = (unsigned)T.krow(j) * (unsigned)(LDK * 2), vs_ = __builtin_amdgcn_readfirstlane(voff * 2u + k0_), ks_ = __builtin_amdgcn_readfirstlane(koff * 2u + k0_); \
    v4u t0_ = __builtin_amdgcn_raw_buffer_load_b128(rsrc, kvv, vs_, 0), t1_ = __builtin_amdgcn_raw_buffer_load_b128(rsrc, kvv, vs_ + 32u * LDK * 2u, 0); \
    v4u t2_ = __builtin_amdgcn_raw_buffer_load_b128(rsrc, kvv, ks_, 0), t3_ = __builtin_amdgcn_raw_buffer_load_b128(rsrc, kvv, ks_ + 32u * LDK * 2u, 0); \
    sr_[i].vs0 = *reinterpret_cast<bf16x8*>(&t0_); sr_[i].vs1 = *reinterpret_cast<bf16x8*>(&t1_); sr_[i].ks0 = *reinterpret_cast<bf16x8*>(&t2_); sr_[i].ks1 = *reinterpret_cast<bf16x8*>(&t3_); } while (0)
#define SWRITE(b, i) do { *(bf16x8*)(V_lds + (b) * SHM_V + vst0) = sr_[i].vs0;          \
    *(bf16x8*)(V_lds + (b) * SHM_V + vst1) = sr_[i].vs1; int kc = sc * 2;               \
    *(bf16x8*)(K_lds + (b) * SHM_K + KSWZ(sr, kc)) = sr_[i].ks0;                       \
    *(bf16x8*)(K_lds + (b) * SHM_K + KSWZ(32 + sr, kc)) = sr_[i].ks1; } while (0)
#define SWAIT() asm volatile("s_waitcnt vmcnt(4)" ::: "memory")
#define RESC(a) do { if (__any((a) < 1.f)) { if (hi == 0) al_l[r32] = (a); asm volatile("s_waitcnt lgkmcnt(0)" ::: "memory"); \
    for (int d = 0; d < 4; ++d) for (int r = 0; r < 16; ++r) o[d][r] *= al_l[crow(r, hi)]; } } while (0)
  f32x16 pA0, pA1, pB0, pB1; float mnA, mnB, alA, alB; bf16x8 pa0, pa1, pa2, pa3; const int NT = T.NT;
  const char* K0 = K_lds + kcolB; const char* K1 = K_lds + SHM_K + kcolB;
  constexpr int SE = 0, SO = 1;
  SLOAD(SE, 0); asm volatile("s_waitcnt vmcnt(0)" ::: "memory"); SWRITE(0, SE); __syncthreads();
  qkt<MODE>(pA0, pA1, K0, qr, r32, hi, MODE == 2 ? T.bias(0) : nullptr, lane); partialSM<MODE>(pA0, pA1, m_reg, mnA, alA);
  SLOAD(SO, 1); if (2 < NT) SLOAD(SE, 2);
  SWAIT(); SWRITE(1, SO); __syncthreads();
  for (int j = 1; j + 1 < NT; j += 2) {
    SBAR(); qkt<MODE>(pB0, pB1, K1, qr, r32, hi, MODE == 2 ? T.bias(j) : nullptr, lane);
    finishSM(pA0, pA1, alA, l_reg, pa0, pa1, pa2, pa3); SBAR();
    SLOAD(SO, j + 2); SBAR();
    pv_d0(o, vb0, pa0, pa1, pa2, pa3); partialSM<MODE>(pB0, pB1, m_reg, mnB, alB);
    __syncthreads(); SWAIT(); SWRITE(0, SE);
    RESC(alB); __syncthreads();
    SBAR(); qkt<MODE>(pA0, pA1, K0, qr, r32, hi, MODE == 2 ? T.bias(j + 1) : nullptr, lane);
    finishSM(pB0, pB1, alB, l_reg, pa0, pa1, pa2, pa3); SBAR();
    if (j + 3 < NT) SLOAD(SE, j + 3); SBAR();
    pv_d0(o, vb0 + (int)SHM_V, pa0, pa1, pa2, pa3); partialSM<MODE>(pA0, pA1, m_reg, mnA, alA);
    __syncthreads(); SWAIT(); SWRITE(1, SO);
    RESC(alA); __syncthreads();
  }
  SBAR(); qkt<MODE>(pB0, pB1, K1, qr, r32, hi, MODE == 2 ? T.bias(NT - 1) : nullptr, lane);
  finishSM(pA0, pA1, alA, l_reg, pa0, pa1, pa2, pa3); SBAR();
  pv_d0(o, vb0, pa0, pa1, pa2, pa3); partialSM<MODE>(pB0, pB1, m_reg, mnB, alB);
  __syncthreads(); RESC(alB);
  finishSM(pB0, pB1, alB, l_reg, pa0, pa1, pa2, pa3); SBAR();
  pv_d0(o, vb0 + (int)SHM_V, pa0, pa1, pa2, pa3);
  if (hi == 0) li_l[r32] = l_reg; asm volatile("s_waitcnt lgkmcnt(0)" ::: "memory");
#pragma unroll
  for (int r = 0; r < 16; ++r) { const float rl = __builtin_amdgcn_rcpf(li_l[crow(r, hi)]);
#pragma unroll
    for (int d0 = 0; d0 < 4; ++d0) o[d0][r] *= rl; }
  __syncthreads();
#undef SLOAD
#undef SWRITE
#undef SWAIT
#undef RESC
}
__device__ __forceinline__ void store_o_bf16(const f32x16 (&o)[4], bf16* Ob, char* lds) {
  const int tid = opaque_tid(), wid = __builtin_amdgcn_readfirstlane(tid >> 6), lane = tid & 63, r32 = lane & 31, hi = lane >> 5;
  char* st = lds + OST_OFF + wid * OST_WAVE;
#pragma unroll
  for (int r = 0; r < 16; ++r) { const int row = crow(r, hi);
#pragma unroll
    for (int d0 = 0; d0 < 4; ++d0) *(unsigned short*)(st + row * OST_STRIDE + (d0 * 32 + r32) * 2) = (unsigned short)f2bf(o[d0][r]); }
  asm volatile("s_waitcnt lgkmcnt(0)" ::: "memory");
#pragma unroll
  for (int i = 0; i < 8; ++i) { const int row = i * 4 + (lane >> 4), ch = lane & 15;
    const v4u w = *(const v4u*)(st + row * OST_STRIDE + ch * 16);
    *(v4u*)(Ob + (size_t)(wid * 32 + row) * D + ch * 8) = w; }
  asm volatile("s_waitcnt lgkmcnt(0)" ::: "memory");
}
#undef KSWZ
}

struct Args { const float* in[26]; float* out; unsigned char* ws; int ph_lo, ph_hi, li, pad; };
enum { I_X = 0, I_C, I_CTX, I_CCTX, I_ADOWN, I_AUP, I_ABIAS, I_NMPRE, I_NMPOST, I_NFPRE, I_NFPOST, I_WIN, I_AQN, I_AKN, I_RPB, I_LQ1, I_LK1, I_LQ2, I_LK2, I_SUBLN, I_WGU, I_BGATE, I_WBR, I_WOUT, I_WFFI, I_WFFO };

__device__ __forceinline__ const float* inp(int i) { asm volatile("" : "+s"(i)); return ((const float* const*)__builtin_amdgcn_kernarg_segment_ptr())[i]; }
__device__ __forceinline__ float* outp() { int i = 26; asm volatile("" : "+s"(i)); return ((float* const*)__builtin_amdgcn_kernarg_segment_ptr())[i]; }
struct Frame {
    LAS unsigned char* lds; unsigned char* ws; int vcu, G;
};

__device__ __forceinline__ void transpose_item(const float* W, int K, int N, bf16* Bt, int k0, int n0, int r0, LAS float* scr, int lane) {
    const float* src = W + (size_t)k0 * N + n0 + (lane & 15) * 4;
#pragma unroll 4
    for (int i = 0; i < 16; ++i) { const int kk = 4 * i + (lane >> 4); const f32x4 v = *(const f32x4*)(src + (size_t)kk * N);
        LAS float* d = scr + kk * 65 + (lane & 15) * 4; d[0] = v[0]; d[1] = v[1]; d[2] = v[2]; d[3] = v[3]; }
    asm volatile("s_waitcnt lgkmcnt(0)" ::: "memory");
    const int c = lane & 7;
#pragma unroll
    for (int j = 0; j < 8; ++j) { const int n = (lane >> 3) + 8 * j; const LAS float* s = scr + (8 * c) * 65 + n;
        v4u o; o.x = pk2(s[0 * 65], s[1 * 65]); o.y = pk2(s[2 * 65], s[3 * 65]); o.z = pk2(s[4 * 65], s[5 * 65]); o.w = pk2(s[6 * 65], s[7 * 65]);
        *(v4u*)(Bt + (size_t)(r0 + n) * K + k0 + 8 * c) = o; }
    asm volatile("s_waitcnt lgkmcnt(0)" ::: "memory");
}
__device__ __forceinline__ void phase_p0(const Frame& F, const Args& A) {
    const int tid_ = opaque_tid(), lane_ = tid_ & 63, wave_ = __builtin_amdgcn_readfirstlane(tid_ >> 6); (void)tid_; (void)lane_; (void)wave_;
    const int gw = F.vcu * 8 + wave_, NGW = F.G * 8;
    for (int it = gw; it < 256; it += NGW) {
        const int l = it >> 6, jb = (it >> 4) & 3, kc = it & 15, j = jb * 64 + lane_;
        const float* wd = inp(I_ADOWN) + (size_t)l * D * ADAR; float acc[5] = {0.f, 0.f, 0.f, 0.f, 0.f};
        for (int k = kc * 256; k < kc * 256 + 256; ++k) { const float w = wd[(size_t)k * ADAR + j];
#pragma unroll
            for (int r = 0; r < 5; ++r) { const float cv = (r < 4) ? inp(I_C)[r * D + k] : inp(I_CCTX)[k]; acc[r] += cv * pg8::sigm(cv) * w; } }
        float* t1p = (float*)(F.ws + WS_T1P);
#pragma unroll
        for (int r = 0; r < 5; ++r) t1p[((l * 16 + kc) * 5 + r) * 256 + j] = acc[r];
    }
    LAS float* scr = (LAS float*)(F.lds + wave_ * 16640);
    constexpr int I0 = (D / 64) * (INW / 64), I1 = (GRK / 64) * (3 * D / 64), I2 = (D / 64) * (D / 64), I3 = I2, I4 = (D / 64) * (2 * DFF / 64), I5 = (DFF / 64) * (D / 64), IL = I0 + I1 + I2 + I3 + I4 + I5;
    for (int it = gw; it < DEPTH * IL; it += NGW) {
        const int l = it / IL; int r = it % IL; unsigned char* wb = F.ws + WS_W + (size_t)l * W_LAYER;
        if (r < I0) { const int nb = INW / 64; transpose_item(inp(I_WIN) + (size_t)l * D * INW, D, INW, (bf16*)(wb + W_IN), (r / nb) * 64, (r % nb) * 64, (r % nb) * 64, scr, lane_); continue; } r -= I0;
        if (r < I1) { const int nb = 3 * D / 64; transpose_item(inp(I_WGU) + (size_t)l * GRK * 3 * D, GRK, 3 * D, (bf16*)(wb + W_GATE), (r / nb) * 64, (r % nb) * 64, (r % nb) * 64, scr, lane_); continue; } r -= I1;
        if (r < I2) { const int nb = D / 64; transpose_item(inp(I_WBR) + (size_t)l * D * D, D, D, (bf16*)(wb + W_BR), (r / nb) * 64, (r % nb) * 64, (r % nb) * 64, scr, lane_); continue; } r -= I2;
        if (r < I3) { const int nb = D / 64; transpose_item(inp(I_WOUT) + (size_t)l * D * D, D, D, (bf16*)(wb + W_OUT), (r / nb) * 64, (r % nb) * 64, (r % nb) * 64, scr, lane_); continue; } r -= I3;
        if (r < I4) { const int nb = 2 * DFF / 64; const int n0 = (r % nb) * 64, hf = n0 / DFF, cc = n0 % DFF, r0 = (cc / 128) * 256 + hf * 128 + (cc % 128);
            transpose_item(inp(I_WFFI) + (size_t)l * D * 2 * DFF, D, 2 * DFF, (bf16*)(wb + W_FFI), (r / nb) * 64, n0, r0, scr, lane_); continue; } r -= I4;
        { const int nb = D / 64; transpose_item(inp(I_WFFO) + (size_t)l * DFF * D, DFF, D, (bf16*)(wb + W_FFO), (r / nb) * 64, (r % nb) * 64, (r % nb) * 64, scr, lane_); }
    }
}
__device__ __forceinline__ void phase_p1(const Frame& F, const Args& A) {
    const int tid_ = opaque_tid(), lane_ = tid_ & 63, wave_ = __builtin_amdgcn_readfirstlane(tid_ >> 6); (void)tid_; (void)lane_; (void)wave_;
    const int gw = F.vcu * 8 + wave_, NGW = F.G * 8;
    LAS float* tl = (LAS float*)(F.lds + wave_ * 8192);
    for (int it = gw; it < DEPTH * 96; it += NGW) {
        const int l = it / 96, nb = it % 96, n4 = nb * 256 + lane_ * 4;
        const float* t1p = (const float*)(F.ws + WS_T1P);
#pragma unroll
        for (int q = 0; q < 4; ++q)
#pragma unroll
            for (int r = 0; r < 5; ++r) { const int j = lane_ + 64 * q; float s = 0.f;
                for (int kc = 0; kc < 16; ++kc) s += __hip_atomic_load(t1p + ((l * 16 + kc) * 5 + r) * 256 + j, RLX_AGENT);
                tl[r * 256 + j] = s; }
        asm volatile("s_waitcnt lgkmcnt(0)" ::: "memory");
        const float* wu = inp(I_AUP) + (size_t)l * ADAR * 6 * D + n4;
        f32x4 acc[5];
#pragma unroll
        for (int r = 0; r < 5; ++r) acc[r] = (f32x4){0.f, 0.f, 0.f, 0.f};
#pragma unroll 4
        for (int j = 0; j < ADAR; ++j) { const f32x4 w = *(const f32x4*)(wu + (size_t)j * 6 * D);
#pragma unroll
            for (int r = 0; r < 5; ++r) acc[r] += w * tl[r * 256 + j]; }
        const f32x4 bv = *(const f32x4*)(inp(I_ABIAS) + (size_t)l * 6 * D + n4);
        float* mod = (float*)(F.ws + WS_MOD);
#pragma unroll
        for (int r = 0; r < 5; ++r) *(f32x4*)(mod + ((size_t)l * 5 + r) * 6 * D + n4) = acc[r] + bv;
        asm volatile("s_waitcnt lgkmcnt(0)" ::: "memory");
    }
    const int gt = F.vcu * 512 + tid_, NGT = F.G * 512;
    for (int e = gt; e < 64 * 32 + 64 * 16; e += NGT) {
        float* rp = (float*)(F.ws + WS_ROPE);
        if (e < 2048) { const int pos = e >> 5, i = e & 31; const double a = (double)pos * exp(-9.210340371976184 * (double)i / 32.0); rp[e] = (float)cos(a); rp[2048 + e] = (float)sin(a); }
        else { const int e2 = e - 2048, pos = e2 >> 4, i = e2 & 15; const double a = (double)pos * exp(-9.210340371976184 * (double)i / 16.0); rp[4096 + e2] = (float)cos(a); rp[4096 + 1024 + e2] = (float)sin(a); }
    }
    for (int e = gt; e < 4 * 8 * 15 * 2 * 2048; e += NGT) {
        const int j = e & 3, ln = (e >> 2) & 63, g = (e >> 8) & 7, half = (e >> 11) & 1, rest = e >> 12, dr = rest % 15, lh = rest / 15;
        const int qc = half * 32 + (ln & 31), hi = ln >> 5, kc = ((g < 4) ? 0 : 32) + j + 8 * (g & 3) + 4 * hi;
        int c0 = qc - 8; c0 = c0 < 0 ? 0 : (c0 > 48 ? 48 : c0);
        const bool valid = (kc >= c0) && (kc < c0 + 16);
        int idx = kc - qc + 15; idx = idx < 0 ? 0 : (idx > 30 ? 30 : idx);
        const float v = valid ? inp(I_RPB)[((size_t)lh * 15 + dr) * 31 + idx] * 11.313708498984761f : -1e30f;
        ((float*)(F.ws + WS_BIAS))[e] = v;
    }
    for (int e = gt; e < 4096; e += NGT) ((float*)(F.ws + WS_BMASK))[e] = (e < 2048) ? -1e30f : 0.f;
    if (gw == 0) {
        for (int l = 0; l < DEPTH; ++l) {
            const float a = wave_sum(inp(I_LQ1)[l * 64 + lane_] * inp(I_LK1)[l * 64 + lane_]), b = wave_sum(inp(I_LQ2)[l * 64 + lane_] * inp(I_LK2)[l * 64 + lane_]);
            const float lam_init = 0.8f - 0.6f * expf(-0.3f * (float)l);
            if (lane_ == 0) ((float*)(F.ws + WS_LAM))[l] = expf(a) - expf(b) + lam_init;
        }
    }
}
template <int MODE>
__device__ __forceinline__ void phase_rows(const Frame& F, const Args& A, const float* gpost, const float* modA  , const float* gpre, const float* modSh, const float* modSc) {
    const int tid_ = opaque_tid(), lane_ = tid_ & 63, wave_ = __builtin_amdgcn_readfirstlane(tid_ >> 6); (void)tid_; (void)lane_; (void)wave_;
    const int gw = F.vcu * 8 + wave_, NGW = F.G * 8;
    float* X = (float*)(F.ws + WS_X); const float* Y = (const float*)(F.ws + WS_Y); bf16* H = (bf16*)(F.ws + WS_H);
    for (int m = gw; m < M; m += NGW) {
        const int b = m / TPB, i = m % TPB, mr = (i < CTXL) ? 4 : b; const size_t mo = (size_t)mr * 6 * D;
        f32x4 x[16];
        float* xr = X + (size_t)m * D + lane_ * 4;
        if constexpr (MODE == 0) {
            const float* src = (i < CTXL) ? inp(I_CTX) + ((size_t)b * CTXL + i) * D : inp(I_X) + ((size_t)b * SEQ + (i - CTXL)) * D;
#pragma unroll
            for (int q = 0; q < 16; ++q) { x[q] = *(const f32x4*)(src + lane_ * 4 + q * 256); *(f32x4*)(xr + q * 256) = x[q]; }
        } else {
            f32x4 y[16]; float ss = 0.f; const float* yr = Y + (size_t)m * D + lane_ * 4;
#pragma unroll
            for (int q = 0; q < 16; ++q) { y[q] = *(const f32x4*)(yr + q * 256); x[q] = *(const f32x4*)(xr + q * 256); ss += (y[q][0] * y[q][0] + y[q][1] * y[q][1]) + (y[q][2] * y[q][2] + y[q][3] * y[q][3]); }
            const float rs = 1.0f / sqrtf(wave_sum(ss) * (1.0f / D) + EPS);
#pragma unroll
            for (int q = 0; q < 16; ++q) { const f32x4 gp = *(const f32x4*)(gpost + lane_ * 4 + q * 256), ga = *(const f32x4*)(modA + mo + lane_ * 4 + q * 256);
                x[q] = x[q] + ga * ((y[q] * rs) * gp); }
            if constexpr (MODE == 2) {
                if (i >= CTXL) { float* orow = outp() + ((size_t)b * SEQ + (i - CTXL)) * D + lane_ * 4;
#pragma unroll
                    for (int q = 0; q < 16; ++q) *(f32x4*)(orow + q * 256) = x[q]; }
            } else {
#pragma unroll
                for (int q = 0; q < 16; ++q) *(f32x4*)(xr + q * 256) = x[q];
            }
        }
        if constexpr (MODE != 2) {
            float ss = 0.f;
#pragma unroll
            for (int q = 0; q < 16; ++q) ss += (x[q][0] * x[q][0] + x[q][1] * x[q][1]) + (x[q][2] * x[q][2] + x[q][3] * x[q][3]);
            const float rs = 1.0f / sqrtf(wave_sum(ss) * (1.0f / D) + EPS);
            bf16* hr = H + (size_t)m * D + lane_ * 4;
#pragma unroll
            for (int q = 0; q < 16; ++q) { const f32x4 g = *(const f32x4*)(gpre + lane_ * 4 + q * 256), sc = *(const f32x4*)(modSc + mo + lane_ * 4 + q * 256), sh = *(const f32x4*)(modSh + mo + lane_ * 4 + q * 256);
                const f32x4 h = ((x[q] * rs) * g) * (1.0f + sc) + sh;
                v2u w; w.x = pk2(h[0], h[1]); w.y = pk2(h[2], h[3]); *(v2u*)(hr + q * 256) = w; }
        }
    }
}
__device__ __forceinline__ void phase_qk(const Frame& F, const Args& A, int l) {
    const int tid_ = opaque_tid(), lane_ = tid_ & 63, wave_ = __builtin_amdgcn_readfirstlane(tid_ >> 6); (void)tid_; (void)lane_; (void)wave_;
    const int gw = F.vcu * 8 + wave_, NGW = F.G * 8;
    bf16* P = (bf16*)(F.ws + WS_PROJ); const float* rp = (const float*)(F.ws + WS_ROPE);
    const float* gq = inp(I_AQN) + l * HD; const float* gk = inp(I_AKN) + l * HD;
    for (int m = gw; m < M; m += NGW) {
        const int i = m % TPB; const bool lat = i >= CTXL; const int t = i - CTXL, prow = t >> 6, pcol = t & 63;
        bf16* row = P + (size_t)m * INW;
#pragma unroll
        for (int s = 0; s < 5; ++s) {
            const int col = s * 512 + lane_ * 8, d = col & 127;
            v4u w = *(const v4u*)(row + col);
            float v[8] = {bflo(w.x), bfhi(w.x), bflo(w.y), bfhi(w.y), bflo(w.z), bfhi(w.z), bflo(w.w), bfhi(w.w)};
            float ss = 0.f;
#pragma unroll
            for (int j = 0; j < 8; ++j) ss += v[j] * v[j];
            ss += __shfl_xor(ss, 1); ss += __shfl_xor(ss, 2); ss += __shfl_xor(ss, 4); ss += __shfl_xor(ss, 8);
            const float rs = 1.0f / sqrtf(ss * (1.0f / HD) + EPS);
            const float* g = (col < C_AK) ? gq : gk;
            const f32x4 g0 = *(const f32x4*)(g + d), g1 = *(const f32x4*)(g + d + 4);
#pragma unroll
            for (int j = 0; j < 4; ++j) { v[j] = v[j] * rs * g0[j]; v[4 + j] = v[4 + j] * rs * g1[j]; }
            if (lat) {
                const int p0 = d >> 1; const int pos = (p0 < 32) ? prow : pcol; const int fi = p0 & 31;
                const f32x4 cs = *(const f32x4*)(rp + pos * 32 + fi), sn = *(const f32x4*)(rp + 2048 + pos * 32 + fi);
#pragma unroll
                for (int j = 0; j < 4; ++j) { const float a = v[2 * j], b2 = v[2 * j + 1]; v[2 * j] = a * cs[j] - b2 * sn[j]; v[2 * j + 1] = a * sn[j] + b2 * cs[j]; }
            }
            w.x = pk2(v[0], v[1]); w.y = pk2(v[2], v[3]); w.z = pk2(v[4], v[5]); w.w = pk2(v[6], v[7]);
            *(v4u*)(row + col) = w;
        }
        if (lat) {
#pragma unroll
            for (int s = 0; s < 4; ++s) {
                const int col = C_CQ + s * 512 + lane_ * 8, d = col & 63;
                v4u w = *(const v4u*)(row + col);
                float v[8] = {bflo(w.x), bfhi(w.x), bflo(w.y), bfhi(w.y), bflo(w.z), bfhi(w.z), bflo(w.w), bfhi(w.w)};
                const int p0 = d >> 1; const int pos = (p0 < 16) ? prow : pcol; const int fi = p0 & 15;
                const f32x4 cs = *(const f32x4*)(rp + 4096 + pos * 16 + fi), sn = *(const f32x4*)(rp + 4096 + 1024 + pos * 16 + fi);
#pragma unroll
                for (int j = 0; j < 4; ++j) { const float a = v[2 * j], b2 = v[2 * j + 1]; v[2 * j] = a * cs[j] - b2 * sn[j]; v[2 * j + 1] = a * sn[j] + b2 * cs[j]; }
                w.x = pk2(v[0], v[1]); w.y = pk2(v[2], v[3]); w.z = pk2(v[4], v[5]); w.w = pk2(v[6], v[7]);
                *(v4u*)(row + col) = w;
            }
        }
    }
}
__device__ __forceinline__ void phase_attn(const Frame& F, const Args& A, int l) {
    const int tid_ = opaque_tid(), lane_ = tid_ & 63, wave_ = __builtin_amdgcn_readfirstlane(tid_ >> 6); (void)tid_; (void)lane_; (void)wave_;
    char* lds = (char*)F.lds;
    const bf16* P = (const bf16*)(F.ws + WS_PROJ); bf16* MIX = (bf16*)(F.ws + WS_MIX);
    const bool last = (l == DEPTH - 1);
    if (PHM & 0x1000) {
        const int nU = 1024 + (last ? 0 : 96);
        for (int u = F.vcu; u < nU; u += F.G) {
            int b, qrow, kcol, vcol, qcol, ocol, nt;
            if (u < 1024) { const int qb = u & 15, hq = (u >> 4) & 15; b = u >> 8; qrow = CTXL + qb * 256; qcol = C_AQ + hq * HD; kcol = C_AK + (hq >> 2) * HD; vcol = C_AV + (hq >> 2) * HD; ocol = hq * HD; nt = TPB / 64; }
            else if (u < 1088) { const int v = u - 1024, hq = v & 15; b = v >> 4; qrow = 0; qcol = C_AQ + hq * HD; kcol = C_AK + (hq >> 2) * HD; vcol = C_AV + (hq >> 2) * HD; ocol = hq * HD; nt = CTXL / 64; }
            else { const int v = u - 1088, hb = v & 7; b = v >> 3; qrow = 0; qcol = C_BQ + hb * HD; kcol = C_BK + hb * HD; vcol = C_BV + hb * HD; ocol = 2048 + hb * HD; nt = CTXL / 64; }
            att::Tiles T; T.NT = nt; T.jmax = nt - 1; T.jsplit = 1 << 30; T.extra = 0; T.btab = nullptr; T.bmask = nullptr; T.bzero = nullptr; T.rlo = T.nrows = T.Rw = T.r0w = T.half = 0;
            const size_t rb = (size_t)b * TPB;
            f32x16 o[4];
            att::attn_core<0>(P, (unsigned)((rb + qrow) * INW + qcol), (unsigned)(rb * INW + kcol), (unsigned)(rb * INW + vcol), T, 0, lds, o);
            att::store_o_bf16(o, MIX + (rb + qrow) * D + ocol, lds);
        }
    }
    if (PHM & 0x2000) {
        for (int u = F.vcu; u < 512; u += F.G) {
            const int qb = u & 15, hb = (u >> 4) & 7, b = u >> 7;
            int rlo = 4 * qb - 4; rlo = rlo < 0 ? 0 : (rlo > 56 ? 56 : rlo);
            int rh = 4 * qb + 3 - 4; rh = rh < 0 ? 0 : (rh > 56 ? 56 : rh); const int nrows = rh + 8 - rlo;
            att::Tiles T; T.NT = (4 + nrows + 1) & ~1; T.jmax = 4 + nrows - 1; T.jsplit = 4; T.extra = rlo * 64;
            T.btab = (const float*)(F.ws + WS_BIAS) + (size_t)(l * 8 + hb) * 15 * 2 * 2048; T.bmask = (const float*)(F.ws + WS_BMASK); T.bzero = T.bmask + 2048;
            T.rlo = rlo; T.nrows = nrows; T.Rw = 4 * qb + (wave_ >> 1); { int r0 = T.Rw - 4; T.r0w = r0 < 0 ? 0 : (r0 > 56 ? 56 : r0); } T.half = wave_ & 1;
            const size_t rb = (size_t)b * TPB; const int qrow = CTXL + qb * 256;
            f32x16 o[4];
            att::attn_core<2>(P, (unsigned)((rb + qrow) * INW + C_BQ + hb * HD), (unsigned)(rb * INW + C_BK + hb * HD), (unsigned)(rb * INW + C_BV + hb * HD), T, 0, lds, o);
            att::store_o_bf16(o, MIX + (rb + qrow) * D + 2048 + hb * HD, lds);
        }
    }
    if (PHM & 0x4000) {
        const float lam = __hip_atomic_load((const float*)(F.ws + WS_LAM) + l, RLX_AGENT);
        const float lam_init = 0.8f - 0.6f * expf(-0.3f * (float)l);
        float* scr = (float*)(F.ws + WS_Y) + (size_t)blockIdx.x * 32768 + wave_ * 4096 + lane_ * 64;
        const float* gs = inp(I_SUBLN) + l * HD;
        const int nU = 512 + (last ? 0 : 32);
        for (int u = F.vcu; u < nU; u += F.G) {
            int b, hc, qrow, nt;
            if (u < 512) { const int qb = u & 15; hc = (u >> 4) & 7; b = u >> 7; qrow = CTXL + qb * 256; nt = TPB / 64; }
            else { const int v = u - 512; hc = v & 7; b = v >> 3; qrow = 0; nt = CTXL / 64; }
            att::Tiles T; T.NT = nt; T.jmax = nt - 1; T.jsplit = 1 << 30; T.extra = 0; T.btab = nullptr; T.bmask = nullptr; T.bzero = nullptr; T.rlo = T.nrows = T.Rw = T.r0w = T.half = 0;
            const size_t rb = (size_t)b * TPB;
#pragma unroll 1
            for (int comp = 0; comp < 2; ++comp) {
                f32x16 o[4];
                att::attn_core<1>(P, (unsigned)((rb + qrow) * INW + C_CQ + hc * HD + comp * 64), (unsigned)(rb * INW + C_CK + hc * HD), (unsigned)(rb * INW + C_CV + hc * HD), T, comp * 128, lds, o);
                if (comp == 0) {
#pragma unroll
                    for (int d0 = 0; d0 < 4; ++d0)
#pragma unroll
                        for (int q = 0; q < 4; ++q) *(f32x4*)(scr + d0 * 16 + q * 4) = (f32x4){o[d0][4 * q], o[d0][4 * q + 1], o[d0][4 * q + 2], o[d0][4 * q + 3]};
                } else {
                    const int r32 = lane_ & 31;
#pragma unroll
                    for (int d0 = 0; d0 < 4; ++d0)
#pragma unroll
                        for (int q = 0; q < 4; ++q) { const f32x4 t = *(const f32x4*)(scr + d0 * 16 + q * 4);
#pragma unroll
                            for (int j = 0; j < 4; ++j) o[d0][4 * q + j] = t[j] - lam * o[d0][4 * q + j]; }
                    float gv[4];
#pragma unroll
                    for (int d0 = 0; d0 < 4; ++d0) gv[d0] = gs[d0 * 32 + r32] * (1.0f - lam_init);
#pragma unroll
                    for (int r = 0; r < 16; ++r) { float ss = (o[0][r] * o[0][r] + o[1][r] * o[1][r]) + (o[2][r] * o[2][r] + o[3][r] * o[3][r]);
                        ss += __shfl_xor(ss, 1); ss += __shfl_xor(ss, 2); ss += __shfl_xor(ss, 4); ss += __shfl_xor(ss, 8); ss += __shfl_xor(ss, 16);
                        const float rs = 1.0f / sqrtf(ss * (1.0f / HD) + EPS);
#pragma unroll
                        for (int d0 = 0; d0 < 4; ++d0) o[d0][r] = o[d0][r] * rs * gv[d0]; }
                    att::store_o_bf16(o, MIX + (rb + qrow) * D + 3072 + hc * HD, lds);
                }
            }
        }
    }
}

constexpr int NPH_LAYER = 9;
constexpr int NPHASES = 3 + DEPTH * NPH_LAYER;

__global__ void __launch_bounds__(512, 2) trunk_fwd(Args args) {
    extern __shared__ __attribute__((aligned(16))) unsigned char lds_raw[];
    Frame F;
    F.lds = (LAS unsigned char*)lds_raw; F.ws = args.ws;
    F.G = gridDim.x; { const int bx = blockIdx.x; F.vcu = (F.G % 8 == 0) ? (bx % 8) * (F.G / 8) + bx / 8 : bx; }
    volatile LAS unsigned* MISC = (volatile LAS unsigned*)(F.lds + MISC_OFF);
    if (threadIdx.x < 64) MISC[threadIdx.x] = 0u;
    __syncthreads();
    unsigned* ctl = (unsigned*)(args.ws + WS_CTL);
    XcdBarrier bar; bar.bar = ctl + CW_BAR; bar.x = 0; bar.st = nullptr;
    const int lo = args.ph_lo, hi = args.ph_hi;
    if (hi - lo > 1) bar = xcd_barrier_post(ctl + CW_BAR + args.li * XCD_BAR_WORDS, MISC + 8);
#define IN(k) (lo <= (k) && (k) < hi)
#define SEAM(k) do { if (IN(k) && IN((k) + 1)) xcd_barrier(bar); } while (0)
    const float* MOD = (const float*)(args.ws + WS_MOD);

    if ((PHM & 1) && IN(0)) { phase_p0(F, args); } SEAM(0);
    if ((PHM & 2) && IN(1)) { phase_p1(F, args); } SEAM(1);
    if ((PHM & 4) && IN(2)) { phase_rows<0>(F, args, nullptr, nullptr, inp(I_NMPRE), MOD + 0 * D, MOD + 1 * D); } SEAM(2);

    for (int l = 0; l < DEPTH; ++l) {
        const int pb = 3 + l * NPH_LAYER;
        unsigned char* wb = args.ws + WS_W + (size_t)l * W_LAYER;
        const float* modl = MOD + (size_t)l * 5 * 6 * D;
        if ((PHM & 8) && IN(pb + 0)) {
            pg8::Gemm g{(const bf16*)(args.ws + WS_H), (const bf16*)(wb + W_IN), M, INW, D, D}; pg8::StaticOrder S; S.init(M, INW, F.G, (int)blockIdx.x);
            pg8::EpiBf16<0> E{(bf16*)(args.ws + WS_PROJ), INW, nullptr};
            pg8::gemm_phase<pg8::EpiBf16<0>, pg8::StaticOrder>(F.lds, g, S, E);
        } SEAM(pb + 0);
        if ((PHM & 16) && IN(pb + 1)) { phase_qk(F, args, l); } SEAM(pb + 1);
        if ((PHM & 32) && IN(pb + 2)) {
            phase_attn(F, args, l);
            __syncthreads();
            if (PHM & 0x8000) {
            pg8::Gemm g{(const bf16*)(args.ws + WS_PROJ) + C_GL, (const bf16*)(wb + W_GATE), M, 3 * D, GRK, INW}; pg8::StaticOrder S; S.init(M, 3 * D, F.G, (int)blockIdx.x);
            pg8::EpiBf16<2> E{(bf16*)(args.ws + WS_G), 3 * D, inp(I_BGATE) + (size_t)l * 3 * D};
            pg8::gemm_phase<pg8::EpiBf16<2>, pg8::StaticOrder>(F.lds, g, S, E); }
        } SEAM(pb + 2);
        if ((PHM & 64) && IN(pb + 3)) {
            pg8::Gemm g{(const bf16*)(args.ws + WS_MIX), (const bf16*)(wb + W_BR), M, D, D, D}; pg8::StaticOrder S; S.init(M, D, F.G, (int)blockIdx.x);
            pg8::EpiHorner E{(bf16*)(args.ws + WS_MRG), D, (const bf16*)(args.ws + WS_G)};
            pg8::gemm_phase<pg8::EpiHorner, pg8::StaticOrder>(F.lds, g, S, E);
        } SEAM(pb + 3);
        if ((PHM & 128) && IN(pb + 4)) {
            pg8::Gemm g{(const bf16*)(args.ws + WS_MRG), (const bf16*)(wb + W_OUT), M, D, D, D}; pg8::StaticOrder S; S.init(M, D, F.G, (int)blockIdx.x);
            pg8::EpiF32 E{(float*)(args.ws + WS_Y), D};
            pg8::gemm_phase<pg8::EpiF32, pg8::StaticOrder>(F.lds, g, S, E);
        } SEAM(pb + 4);
        if ((PHM & 256) && IN(pb + 5)) { phase_rows<1>(F, args, inp(I_NMPOST) + (size_t)l * D, modl + 2 * D, inp(I_NFPRE) + (size_t)l * D, modl + 3 * D, modl + 4 * D); } SEAM(pb + 5);
        if ((PHM & 512) && IN(pb + 6)) {
            pg8::Gemm g{(const bf16*)(args.ws + WS_H), (const bf16*)(wb + W_FFI), M, 2 * DFF, D, D}; pg8::StaticOrder S; S.init(M, 2 * DFF, F.G, (int)blockIdx.x);
            pg8::EpiSwiGLU E{(bf16*)(args.ws + WS_ACT), DFF};
            pg8::gemm_phase<pg8::EpiSwiGLU, pg8::StaticOrder>(F.lds, g, S, E);
        } SEAM(pb + 6);
        if ((PHM & 1024) && IN(pb + 7)) {
            pg8::Gemm g{(const bf16*)(args.ws + WS_ACT), (const bf16*)(wb + W_FFO), M, D, DFF, DFF}; pg8::StaticOrder S; S.init(M, D, F.G, (int)blockIdx.x);
            pg8::EpiF32 E{(float*)(args.ws + WS_Y), D};
            pg8::gemm_phase<pg8::EpiF32, pg8::StaticOrder>(F.lds, g, S, E);
        } SEAM(pb + 7);
        if ((PHM & 2048) && IN(pb + 8)) {
            if (l < DEPTH - 1) phase_rows<1>(F, args, inp(I_NFPOST) + (size_t)l * D, modl + 5 * D, inp(I_NMPRE) + (size_t)(l + 1) * D, modl + 5 * 6 * D + 0 * D, modl + 5 * 6 * D + 1 * D);
            else phase_rows<2>(F, args, inp(I_NFPOST) + (size_t)l * D, modl + 5 * D, nullptr, nullptr, nullptr);
        } SEAM(pb + 8);
    }
#undef IN
#undef SEAM
}

extern "C" void kernel_launch(void* const* d_in, const int* in_sizes, int n_in, void* d_out, int out_size, void* d_ws, size_t ws_size, hipStream_t stream) {
    static int grid = 0;
    if (grid == 0) {
        if (n_in != 26 || in_sizes[0] != NB * SEQ * D || out_size != NB * SEQ * D || ws_size < WS_END) { fprintf(stderr, "kernel_launch: shape mismatch (n_in %d, in0 %d, out %d, ws %zu < %zu)\n", n_in, n_in > 0 ? in_sizes[0] : -1, out_size, ws_size, (size_t)WS_END); grid = -1; return; }
        int dev = 0, cus = 0, per_cu = 0;
        if (hipGetDevice(&dev) != hipSuccess || hipDeviceGetAttribute(&cus, hipDeviceAttributeMultiprocessorCount, dev) != hipSuccess) { grid = -1; return; }
        if (hipFuncSetAttribute((const void*)trunk_fwd, hipFuncAttributeMaxDynamicSharedMemorySize, LDS_BYTES) != hipSuccess) { fprintf(stderr, "kernel_launch: hipFuncSetAttribute failed\n"); grid = -1; return; }
        if (hipOccupancyMaxActiveBlocksPerMultiprocessor(&per_cu, (const void*)trunk_fwd, 512, LDS_BYTES) != hipSuccess || per_cu < 1) fprintf(stderr, "kernel_launch: occupancy query says %d\n", per_cu);
        (void)hipGetLastError();
        grid = cus;
    }
    if (grid < 0) return;
    (void)hipMemsetAsync((char*)d_ws + WS_CTL, 0, CTL_ZERO_BYTES, stream);
    Args a{};
    for (int i = 0; i < 26; ++i) a.in[i] = (const float*)d_in[i];
    a.out = (float*)d_out; a.ws = (unsigned char*)d_ws; a.pad = 0;
#if MK_PER_PHASE
    for (int p = 0; p < NPHASES; ++p) { a.ph_lo = p; a.ph_hi = p + 1; a.li = 0; hipLaunchKernelGGL(trunk_fwd, dim3(grid), dim3(512), LDS_BYTES, stream, a); }
#else
    a.ph_lo = 0; a.ph_hi = NPHASES; a.li = 0; hipLaunchKernelGGL(trunk_fwd, dim3(grid), dim3(512), LDS_BYTES, stream, a);
#endif
    const hipError_t le = hipPeekAtLastError();
    if (le != hipSuccess) fprintf(stderr, "kernel_launch: launch failed: %s\n", hipGetErrorName(le));
}
```

```cpp
#include <hip/hip_runtime.h>
#include <cstdio>
#include <cstdint>

#ifndef PHM
#define PHM 0xffff
#endif
#ifndef MK_PER_PHASE
#define MK_PER_PHASE 0
#endif

__device__ __forceinline__ int opaque_tid() { int t = threadIdx.x; asm volatile("" : "+v"(t)); return t; }
namespace pg8 {
#define PG8_LAS __attribute__((address_space(3)))
typedef unsigned short bf16_t;
typedef short bf16x8 __attribute__((ext_vector_type(8)));
typedef float f32x4 __attribute__((ext_vector_type(4)));
typedef unsigned u32x4 __attribute__((ext_vector_type(4)));
constexpr int BM = 256, BK = 64, HALF = 128, HTB = HALF * BK * 2, STAGE_BYTES = 8 * HTB, NXCD = 8, WGM = 8;

__host__ __device__ __forceinline__ int lds_byte(int r, int c) { const int st = (r >> 4) * 2 + (c >> 5), rr = r & 15, cc = c & 31, ob = rr * 64 + cc * 2; return st * 1024 + (ob ^ (((ob >> 9) & 1) << 5)); }
__host__ __device__ __forceinline__ void stage_rc(int b, int& R, int& C) { const int st = b / 1024, sb = b % 1024, swz = sb ^ (((sb >> 9) & 1) << 5); R = (st >> 1) * 16 + swz / 64; C = (st & 1) * 32 + (swz % 64) / 2; }
__host__ __device__ __forceinline__ int perm32(int rho) { const int n = rho >> 4, i = rho & 15; return 8 * (i >> 2) + 4 * n + (i & 3); }

struct Unit { int pm, pn; };
struct Gemm { const bf16_t* A; const bf16_t* Bt; int M, N, K, lda; };

struct StaticOrder {
    int nM, nN, nwg, G, c;
    __host__ __device__ void init(int M, int N, int G_, int c_) { nM = M / BM; nN = N / BM; nwg = nM * nN; G = G_; c = c_; }
    __host__ __device__ bool next(int i, Unit& u) const {
        const long L = (long)i * G + c; if (L >= nwg) return false;
        int wgid = (int)L; { const int q = nwg / NXCD, r = nwg % NXCD, xcd = wgid % NXCD, off = wgid / NXCD; wgid = (xcd < r ? xcd * (q + 1) : r * (q + 1) + (xcd - r) * q) + off; }
        const int nig = WGM * nN, gid = wgid / nig, fm = gid * WGM, gsz = (nM - fm) < WGM ? (nM - fm) : WGM;
        u.pm = fm + ((wgid % nig) % gsz); u.pn = (wgid % nig) / gsz; return true;
    }
    __device__ __forceinline__ void a_ready(const Unit&) const {}
    __device__ __forceinline__ void done(const Unit&) const {}
};

__device__ __forceinline__ unsigned cvt_pk_bf16(float lo, float hi) { unsigned r; asm volatile("v_cvt_pk_bf16_f32 %0, %1, %2" : "=v"(r) : "v"(lo), "v"(hi)); return r; }
__device__ __forceinline__ float sigm(float x) { return __builtin_amdgcn_rcpf(1.0f + __builtin_amdgcn_exp2f(-1.4426950408889634f * x)); }
__device__ __forceinline__ f32x4 bf4lo(unsigned a, unsigned b) { return (f32x4){__uint_as_float(a << 16), __uint_as_float(a & 0xffff0000u), __uint_as_float(b << 16), __uint_as_float(b & 0xffff0000u)}; }

template <int ACT> struct EpiBf16 {
    static constexpr bool PERM = true, AFTER_DRAIN = false, HORNER = false;
    bf16_t* O; int ldc; const float* bias;
    __device__ __forceinline__ void mid(f32x4 (&)[2][2][4][2], const Unit&, int, int, int, int, int) const {}
    __device__ __forceinline__ void operator()(const f32x4 (&acc)[2][2][4][2], const Unit& u, int wr, int wc, int fr, int fq) const {
        const int row0 = u.pm * BM + wr * 64 + fr; const int col0 = u.pn * BM + wc * 32 + 8 * fq;
        f32x4 bv[2][2];
#pragma unroll
        for (int bj = 0; bj < 2; ++bj)
#pragma unroll
            for (int n = 0; n < 2; ++n) bv[bj][n] = (ACT == 2) ? *(const f32x4*)(bias + col0 + bj * HALF + 4 * n) : (f32x4){0.f, 0.f, 0.f, 0.f};
#pragma unroll
        for (int ai = 0; ai < 2; ++ai)
#pragma unroll
            for (int m = 0; m < 4; ++m) { bf16_t* rowp = O + (size_t)(row0 + ai * HALF + m * 16) * ldc + col0;
#pragma unroll
                for (int bj = 0; bj < 2; ++bj) { f32x4 v0 = acc[ai][bj][m][0] + bv[bj][0], v1 = acc[ai][bj][m][1] + bv[bj][1];
                    if (ACT == 2) {
#pragma unroll
                        for (int j = 0; j < 4; ++j) { v0[j] = fmaxf(sigm(v0[j]), 1e-12f); v1[j] = fmaxf(sigm(v1[j]), 1e-12f); } }
                    u32x4 w; w.x = cvt_pk_bf16(v0[0], v0[1]); w.y = cvt_pk_bf16(v0[2], v0[3]); w.z = cvt_pk_bf16(v1[0], v1[1]); w.w = cvt_pk_bf16(v1[2], v1[3]);
                    *(u32x4*)(rowp + bj * HALF) = w; } }
    }
};
struct EpiSwiGLU {
    static constexpr bool PERM = true, AFTER_DRAIN = false, HORNER = false;
    bf16_t* O; int ldc;
    __device__ __forceinline__ void mid(f32x4 (&)[2][2][4][2], const Unit&, int, int, int, int, int) const {}
    __device__ __forceinline__ void operator()(const f32x4 (&acc)[2][2][4][2], const Unit& u, int wr, int wc, int fr, int fq) const {
        const int row0 = u.pm * BM + wr * 64 + fr; const int col0 = u.pn * HALF + wc * 32 + 8 * fq;
#pragma unroll
        for (int ai = 0; ai < 2; ++ai)
#pragma unroll
            for (int m = 0; m < 4; ++m) { bf16_t* rowp = O + (size_t)(row0 + ai * HALF + m * 16) * ldc + col0;
                f32x4 g0 = acc[ai][0][m][0], g1 = acc[ai][0][m][1]; const f32x4 u0 = acc[ai][1][m][0], u1 = acc[ai][1][m][1];
#pragma unroll
                for (int j = 0; j < 4; ++j) { g0[j] = g0[j] * sigm(g0[j]) * u0[j]; g1[j] = g1[j] * sigm(g1[j]) * u1[j]; }
                u32x4 w; w.x = cvt_pk_bf16(g0[0], g0[1]); w.y = cvt_pk_bf16(g0[2], g0[3]); w.z = cvt_pk_bf16(g1[0], g1[1]); w.w = cvt_pk_bf16(g1[2], g1[3]);
                *(u32x4*)rowp = w; }
    }
};
struct EpiF32 {
    static constexpr bool PERM = false, AFTER_DRAIN = false, HORNER = false;
    float* C; int ldc;
    __device__ __forceinline__ void mid(f32x4 (&)[2][2][4][2], const Unit&, int, int, int, int, int) const {}
    __device__ __forceinline__ void operator()(const f32x4 (&acc)[2][2][4][2], const Unit& u, int wr, int wc, int fr, int fq) const {
        const int row0 = u.pm * BM + wr * 64 + fr, col0 = u.pn * BM + wc * 32 + 4 * fq;
#pragma unroll
        for (int ai = 0; ai < 2; ++ai)
#pragma unroll
            for (int m = 0; m < 4; ++m) { float* rowp = C + (size_t)(row0 + ai * HALF + m * 16) * ldc + col0;
#pragma unroll
                for (int bj = 0; bj < 2; ++bj)
#pragma unroll
                    for (int n = 0; n < 2; ++n) *(f32x4*)(rowp + bj * HALF + n * 16) = acc[ai][bj][m][n]; }
    }
};
struct EpiHorner {
    static constexpr bool PERM = true, AFTER_DRAIN = false, HORNER = true;
    bf16_t* O; int ldc; const bf16_t* G;
    __device__ __forceinline__ void mid(f32x4 (&acc)[2][2][4][2], const Unit& u, int t, int wr, int wc, int fr, int fq) const {
        const __amdgpu_buffer_rsrc_t rs = __builtin_amdgcn_make_buffer_rsrc((void*)G, 0, (int)(17408u * 12288u * 2u), 0x00020000);
        const unsigned vo = (unsigned)((wr * 64 + fr) * 12288 + wc * 32 + 8 * fq) * 2u;
        const unsigned so0 = (unsigned)__builtin_amdgcn_readfirstlane((u.pm * BM * 12288 + u.pn * BM + ((t == 32) ? 0 : 4096)) * 2);
#pragma unroll
        for (int ai = 0; ai < 2; ++ai)
#pragma unroll
            for (int m = 0; m < 4; ++m)
#pragma unroll
                for (int bj = 0; bj < 2; ++bj) { const unsigned so = so0 + (unsigned)(((ai * HALF + m * 16) * 12288 + bj * HALF) * 2);
                    const u32x4 a = __builtin_amdgcn_raw_buffer_load_b128(rs, vo, so, 0), b = __builtin_amdgcn_raw_buffer_load_b128(rs, vo, so + 8192u, 0);
                    const f32x4 a0 = bf4lo(a.x, a.y), a1 = bf4lo(a.z, a.w), b0 = bf4lo(b.x, b.y), b1 = bf4lo(b.z, b.w);
#pragma unroll
                    for (int j = 0; j < 4; ++j) { acc[ai][bj][m][0][j] *= a0[j] * __builtin_amdgcn_rcpf(b0[j]); acc[ai][bj][m][1][j] *= a1[j] * __builtin_amdgcn_rcpf(b1[j]); }
                    if (bj) asm volatile("" ::: "memory"); }
    }
    __device__ __forceinline__ void operator()(const f32x4 (&acc)[2][2][4][2], const Unit& u, int wr, int wc, int fr, int fq) const {
        const __amdgpu_buffer_rsrc_t rs = __builtin_amdgcn_make_buffer_rsrc((void*)G, 0, (int)(17408u * 12288u * 2u), 0x00020000);
        const unsigned vo = (unsigned)((wr * 64 + fr) * 12288 + wc * 32 + 8 * fq) * 2u;
        const unsigned so0 = (unsigned)__builtin_amdgcn_readfirstlane((u.pm * BM * 12288 + u.pn * BM + 8192) * 2);
        const int row0 = u.pm * BM + wr * 64 + fr; const int col0 = u.pn * BM + wc * 32 + 8 * fq;
#pragma unroll
        for (int ai = 0; ai < 2; ++ai)
#pragma unroll
            for (int m = 0; m < 4; ++m) { bf16_t* rowp = O + (size_t)(row0 + ai * HALF + m * 16) * ldc + col0;
#pragma unroll
                for (int bj = 0; bj < 2; ++bj) { const unsigned so = so0 + (unsigned)(((ai * HALF + m * 16) * 12288 + bj * HALF) * 2);
                    const u32x4 c = __builtin_amdgcn_raw_buffer_load_b128(rs, vo, so, 0); const f32x4 v0 = acc[ai][bj][m][0] * bf4lo(c.x, c.y), v1 = acc[ai][bj][m][1] * bf4lo(c.z, c.w);
                    u32x4 w; w.x = cvt_pk_bf16(v0[0], v0[1]); w.y = cvt_pk_bf16(v0[2], v0[3]); w.z = cvt_pk_bf16(v1[0], v1[1]); w.w = cvt_pk_bf16(v1[2], v1[3]);
                    *(u32x4*)(rowp + bj * HALF) = w; }
                asm volatile("" ::: "memory"); }
    }
};

template <class Epi, class Sched, bool ALIGN_EPI = true, bool SP2 = true>
__device__ __forceinline__ void gemm_phase(PG8_LAS unsigned char* lds, const Gemm g, const Sched& S, const Epi& E) {
    const int tid = opaque_tid(), wid = __builtin_amdgcn_readfirstlane(tid >> 6), lane = tid & 63, wr = wid >> 2, wc = wid & 3, fr = lane & 15, fq = lane >> 4;
    const int K = g.K, nt = K / BK;
    unsigned voffA[2], voffB[2];
#pragma unroll
    for (int i = 0; i < 2; ++i) { int R, C; stage_rc(tid * 16 + i * 8192, R, C); const int Rb = Epi::PERM ? ((R & ~31) + perm32(R & 31)) : R;
        voffA[i] = (unsigned)(R * g.lda + C) * 2u; voffB[i] = (unsigned)(Rb * K + C) * 2u; }
    const size_t kstep = (size_t)(BK * 2);
    const size_t hstepB = (size_t)HALF * K * 2, hstepA = (size_t)HALF * g.lda * 2;
    const size_t tstepB = 2 * hstepB, tstepA = 2 * hstepA;
    const unsigned ldsw = (unsigned)wid * 1024u;
    const int aoff = lds_byte(wr * 64 + fr, fq * 8), boff = lds_byte(wc * 32 + fr, fq * 8);
#define PG8_SA(b, h) (((b) * 2 + (h)) * HTB)
#define PG8_SB(b, h) ((4 + (b) * 2 + (h)) * HTB)
#define PG8_STAGE(bufoff, gbase, voff) do { _Pragma("unroll") for (int _i = 0; _i < 2; ++_i) \
        __builtin_amdgcn_global_load_lds((const unsigned*)((const char*)(gbase) + (voff)[_i]), (PG8_LAS unsigned*)(lds + (bufoff) + ldsw + _i * 8192), 16, 0, 0); } while (0)
#define PG8_LDA(dst, b, h) do { _Pragma("unroll") for (int m = 0; m < 4; ++m) _Pragma("unroll") for (int k = 0; k < 2; ++k) dst[m][k] = *(const PG8_LAS bf16x8*)(lds + PG8_SA(b, h) + aoff + m * 2048 + k * 1024); } while (0)
#define PG8_LDB(dst, b, h) do { _Pragma("unroll") for (int n = 0; n < 2; ++n) _Pragma("unroll") for (int k = 0; k < 2; ++k) dst[n][k] = *(const PG8_LAS bf16x8*)(lds + PG8_SB(b, h) + boff + n * 2048 + k * 1024); } while (0)
#define PG8_MMA(ai, bj, At, Bt) do { __builtin_amdgcn_s_setprio(1); _Pragma("unroll") for (int m = 0; m < 4; ++m) _Pragma("unroll") for (int n = 0; n < 2; ++n) _Pragma("unroll") for (int k = 0; k < 2; ++k) \
        acc[ai][bj][m][n] = __builtin_amdgcn_mfma_f32_16x16x32_bf16(Bt[n][k], At[m][k], acc[ai][bj][m][n], 0, 0, 0); __builtin_amdgcn_s_setprio(0); } while (0)
#define PG8_WAIT_V(n) asm volatile("s_waitcnt vmcnt(" #n ")" ::: "memory")
#define PG8_WAIT_L(n) asm volatile("s_waitcnt lgkmcnt(" #n ")" ::: "memory")
#define PG8_BAR __builtin_amdgcn_s_barrier()
#define PG8_SCHED __builtin_amdgcn_sched_barrier(0)
    Unit cur, nxt; int ui = 0;
    if (!S.next(0, cur)) return;
    f32x4 acc[2][2][4][2];
#pragma unroll
    for (int a = 0; a < 2; ++a)
#pragma unroll
        for (int b = 0; b < 2; ++b)
#pragma unroll
            for (int m = 0; m < 4; ++m)
#pragma unroll
                for (int n = 0; n < 2; ++n) acc[a][b][m][n] = (f32x4){0.f, 0.f, 0.f, 0.f};
    bf16x8 At[4][2], B0[2][2], B1[2][2];
    const char* cA = (const char*)g.A + (size_t)cur.pm * tstepA; const char* cB = (const char*)g.Bt + (size_t)cur.pn * tstepB;
    S.a_ready(cur);
    if constexpr (SP2) {
        PG8_STAGE(PG8_SB(0, 0), cB, voffB); PG8_STAGE(PG8_SB(0, 1), cB + hstepB, voffB); PG8_STAGE(PG8_SA(0, 0), cA, voffA); PG8_STAGE(PG8_SA(0, 1), cA + hstepA, voffA);
        if (wr == 1) PG8_BAR;
        PG8_WAIT_V(2); PG8_BAR;
        PG8_STAGE(PG8_SB(1, 0), cB + kstep, voffB); PG8_STAGE(PG8_SA(1, 0), cA + kstep, voffA); PG8_STAGE(PG8_SB(1, 1), cB + hstepB + kstep, voffB);
        PG8_WAIT_V(6); PG8_BAR;
    } else {
        PG8_STAGE(PG8_SB(0, 0), cB, voffB); PG8_STAGE(PG8_SA(0, 0), cA, voffA); PG8_STAGE(PG8_SB(0, 1), cB + hstepB, voffB); PG8_STAGE(PG8_SA(0, 1), cA + hstepA, voffA);
        if (wr == 1) PG8_BAR;
        PG8_WAIT_V(4); PG8_BAR;
        PG8_STAGE(PG8_SB(1, 0), cB + kstep, voffB); PG8_STAGE(PG8_SA(1, 0), cA + kstep, voffA); PG8_STAGE(PG8_SB(1, 1), cB + hstepB + kstep, voffB);
        PG8_WAIT_V(6); PG8_BAR;
    }
    for (;;) {
        const bool has_next = S.next(ui + 1, nxt);
        const char* nA = has_next ? (const char*)g.A + (size_t)nxt.pm * tstepA : cA; const char* nB = has_next ? (const char*)g.Bt + (size_t)nxt.pn * tstepB : cB;
        for (int t = 0; t < nt; t += 2) {
            const bool last = (t == nt - 2);
            const char* a1 = cA + (size_t)(t + 1) * kstep;
            const char* a2 = last ? nA : cA + (size_t)(t + 2) * kstep; const char* b2 = last ? nB : cB + (size_t)(t + 2) * kstep;
            const char* a3 = a2 + kstep; const char* b3 = b2 + kstep;
            if constexpr (Epi::HORNER) { if (t == 32 || t == 48) E.mid(acc, cur, t, wr, wc, fr, fq); }
            if (last && has_next) S.a_ready(nxt);
            if constexpr (SP2) {
            PG8_LDB(B0, 0, 0); PG8_LDB(B1, 0, 1); PG8_SCHED; PG8_LDA(At, 0, 0); PG8_STAGE(PG8_SA(1, 1), a1 + hstepA, voffA);
            PG8_WAIT_V(8); PG8_WAIT_L(0); PG8_BAR; PG8_MMA(0, 0, At, B0); PG8_MMA(0, 1, At, B1); PG8_BAR; PG8_SCHED;
            PG8_LDA(At, 0, 1); PG8_STAGE(PG8_SB(0, 0), b2, voffB); PG8_STAGE(PG8_SB(0, 1), b2 + hstepB, voffB); PG8_STAGE(PG8_SA(0, 0), a2, voffA);
            PG8_WAIT_V(8); PG8_WAIT_L(0); PG8_BAR; PG8_MMA(1, 0, At, B0); PG8_MMA(1, 1, At, B1); PG8_BAR; PG8_SCHED;
            PG8_LDB(B0, 1, 0); PG8_LDB(B1, 1, 1); PG8_SCHED; PG8_LDA(At, 1, 0); PG8_STAGE(PG8_SA(0, 1), a2 + hstepA, voffA);
            PG8_WAIT_V(8); PG8_WAIT_L(0); PG8_BAR; PG8_MMA(0, 0, At, B0); PG8_MMA(0, 1, At, B1); PG8_BAR; PG8_SCHED;
            PG8_LDA(At, 1, 1); PG8_STAGE(PG8_SB(1, 0), b3, voffB); PG8_STAGE(PG8_SB(1, 1), b3 + hstepB, voffB); PG8_STAGE(PG8_SA(1, 0), a3, voffA);
            PG8_WAIT_V(8); PG8_WAIT_L(0); PG8_BAR; PG8_MMA(1, 0, At, B0); PG8_MMA(1, 1, At, B1); PG8_BAR; PG8_SCHED;
            } else {
            PG8_LDB(B0, 0, 0); PG8_SCHED; PG8_LDA(At, 0, 0); PG8_STAGE(PG8_SA(1, 1), a1 + hstepA, voffA);
            PG8_WAIT_L(8); PG8_BAR; PG8_WAIT_L(0); PG8_MMA(0, 0, At, B0); PG8_BAR; PG8_SCHED;
            PG8_LDB(B1, 0, 1); PG8_STAGE(PG8_SB(0, 0), b2, voffB);
            PG8_BAR; PG8_WAIT_L(0); PG8_MMA(0, 1, At, B1); PG8_BAR;
            PG8_LDA(At, 0, 1); PG8_STAGE(PG8_SA(0, 0), a2, voffA);
            PG8_BAR; PG8_WAIT_L(0); PG8_MMA(1, 0, At, B0); PG8_BAR; PG8_SCHED;
            PG8_STAGE(PG8_SB(0, 1), b2 + hstepB, voffB);
            PG8_WAIT_V(6); PG8_BAR; PG8_MMA(1, 1, At, B1); PG8_BAR;
            PG8_LDB(B0, 1, 0); PG8_SCHED; PG8_LDA(At, 1, 0); PG8_STAGE(PG8_SA(0, 1), a2 + hstepA, voffA);
            PG8_WAIT_L(8); PG8_BAR; PG8_WAIT_L(0); PG8_MMA(0, 0, At, B0); PG8_BAR; PG8_SCHED;
            PG8_LDB(B1, 1, 1); PG8_STAGE(PG8_SB(1, 0), b3, voffB);
            PG8_BAR; PG8_WAIT_L(0); PG8_MMA(0, 1, At, B1); PG8_BAR;
            PG8_LDA(At, 1, 1); PG8_STAGE(PG8_SA(1, 0), a3, voffA);
            PG8_BAR; PG8_WAIT_L(0); PG8_MMA(1, 0, At, B0); PG8_BAR; PG8_SCHED;
            PG8_STAGE(PG8_SB(1, 1), b3 + hstepB, voffB);
            PG8_WAIT_V(6); PG8_BAR; PG8_MMA(1, 1, At, B1); PG8_BAR;
            }
        }
        if constexpr (ALIGN_EPI) { if (wr == 0) PG8_BAR; }
        E(acc, cur, wr, wc, fr, fq); S.done(cur);
        if (!has_next) break;
#pragma unroll
        for (int a = 0; a < 2; ++a)
#pragma unroll
            for (int b = 0; b < 2; ++b)
#pragma unroll
                for (int m = 0; m < 4; ++m)
#pragma unroll
                    for (int n = 0; n < 2; ++n) acc[a][b][m][n] = (f32x4){0.f, 0.f, 0.f, 0.f};
        cur = nxt; cA = nA; cB = nB; ++ui;
        if constexpr (ALIGN_EPI) { if (wr == 1) PG8_BAR; }
    }
    PG8_WAIT_V(0);
    if constexpr (!ALIGN_EPI) { if (wr == 0) PG8_BAR; }
    PG8_BAR;
#undef PG8_SA
#undef PG8_SB
#undef PG8_STAGE
#undef PG8_LDA
#undef PG8_LDB
#undef PG8_MMA
#undef PG8_WAIT_V
#undef PG8_WAIT_L
#undef PG8_BAR
#undef PG8_SCHED
}
}

constexpr int D = 4096, NB = 4, SEQ = 4096, DEPTH = 4, GRIDW = 64, CTXL = 256, HD = 128;
constexpr int TPB = CTXL + SEQ;
constexpr int M = NB * TPB;
constexpr int INW = 9728, DFF = 11008, GRK = 512, ADAR = 256;
constexpr int C_AQ = 0, C_AK = 2048, C_AV = 2560, C_BQ = 3072, C_BK = 4096, C_BV = 5120, C_CQ = 6144, C_CK = 7168, C_CV = 8192, C_GL = 9216;
constexpr float EPS = 1e-6f;

constexpr size_t MiB = 1u << 20;
constexpr size_t WS_CTL = 0, CTL_ZERO_BYTES = 1 * MiB;
constexpr size_t WS_T1P = 1 * MiB;
constexpr size_t WS_MOD = 2 * MiB;
constexpr size_t WS_ROPE = 4 * MiB;
constexpr size_t WS_LAM = 4 * MiB + 65536;
constexpr size_t WS_BMASK = 5 * MiB;
constexpr size_t WS_BIAS = 6 * MiB;
constexpr size_t WS_W = 16 * MiB;
constexpr size_t W_IN = 0, W_GATE = W_IN + (size_t)INW * D * 2, W_BR = W_GATE + (size_t)3 * D * GRK * 2, W_OUT = W_BR + (size_t)D * D * 2,
                 W_FFI = W_OUT + (size_t)D * D * 2, W_FFO = W_FFI + (size_t)2 * DFF * D * 2, W_LAYER = W_FFO + (size_t)D * DFF * 2;
constexpr size_t WS_X = 1664 * MiB;
constexpr size_t WS_H = 1936 * MiB;
constexpr size_t WS_PROJ = 2072 * MiB;
constexpr size_t WS_MIX = 2395 * MiB;
constexpr size_t WS_G = 2531 * MiB;
constexpr size_t WS_MRG = 2939 * MiB;
constexpr size_t WS_Y = 3075 * MiB;
constexpr size_t WS_ACT = 3347 * MiB;
constexpr size_t WS_END = 3713 * MiB;
static_assert(WS_W + DEPTH * W_LAYER <= WS_X && WS_X + (size_t)M * D * 4 <= WS_H && WS_H + (size_t)M * D * 2 <= WS_PROJ && WS_PROJ + (size_t)M * INW * 2 <= WS_MIX &&
              WS_MIX + (size_t)M * D * 2 <= WS_G && WS_G + (size_t)M * 3 * D * 2 <= WS_MRG && WS_MRG + (size_t)M * D * 2 <= WS_Y && WS_Y + (size_t)M * D * 4 <= WS_ACT &&
              WS_ACT + (size_t)M * DFF * 2 <= WS_END && WS_BIAS + (size_t)4 * 8 * 15 * 2 * 2048 * 4 <= WS_W, "d_ws map");
constexpr int CW_BAR = 4096;

constexpr int RING_BYTES = 139264;
constexpr int MISC_OFF = RING_BYTES;
constexpr int LDS_BYTES = 147456;
static_assert(MISC_OFF + 256 <= LDS_BYTES, "LDS map");

#define GAS __attribute__((address_space(1)))
#define LAS __attribute__((address_space(3)))
typedef unsigned short bf16;
typedef unsigned v4u __attribute__((ext_vector_type(4)));
typedef unsigned v2u __attribute__((ext_vector_type(2)));
typedef float f32x4 __attribute__((ext_vector_type(4)));
typedef short bf16x8 __attribute__((ext_vector_type(8)));
typedef short s16x4 __attribute__((ext_vector_type(4)));
typedef float f32x16 __attribute__((ext_vector_type(16)));
#define RLX_AGENT __ATOMIC_RELAXED, __HIP_MEMORY_SCOPE_AGENT
__device__ __forceinline__ unsigned f2bf(float f) { unsigned u = __builtin_bit_cast(unsigned, f); return (u + 0x7fffu + ((u >> 16) & 1u)) >> 16; }
__device__ __forceinline__ unsigned pk2(float lo, float hi) { return pg8::cvt_pk_bf16(lo, hi); }
__device__ __forceinline__ float bflo(unsigned w) { return __uint_as_float(w << 16); }
__device__ __forceinline__ float bfhi(unsigned w) { return __uint_as_float(w & 0xffff0000u); }
__device__ __forceinline__ float wave_sum(float v) {
#pragma unroll
    for (int o = 1; o < 64; o <<= 1) v += __shfl_xor(v, o);
    return v;
}

#define XB_TMO      128
#define XB_XCNT(j)  (256  + 64 * (j))
#define XB_XSUB(j)  (1280 + 64 * (j))
#define XB_XGEN(j)  (2304 + 64 * (j))
#define XB_TOP      3328
#define XB_TOPGEN   3392
#define XCD_BAR_WORDS 3456
#define XB_SPIN_CAP (1u << 22)
__device__ __forceinline__ unsigned xb_ld(unsigned* p)              { return __hip_atomic_load(p, __ATOMIC_RELAXED, __HIP_MEMORY_SCOPE_AGENT); }
__device__ __forceinline__ unsigned xb_add(unsigned* p, unsigned v) { return __hip_atomic_fetch_add(p, v, __ATOMIC_RELAXED, __HIP_MEMORY_SCOPE_AGENT); }
__device__ __forceinline__ unsigned xb_xcc_id() { return (unsigned)__builtin_amdgcn_s_getreg((3 << 11) | 20) & 0xFu; }
#define XB_SPIN(cond, bar) do { unsigned _sp = 0; while (cond) { __builtin_amdgcn_s_sleep(1); \
    if ((++_sp & 255u) == 0u) { if (xb_ld(&(bar)[XB_TMO])) break; if (_sp > XB_SPIN_CAP) { atomicAdd(&(bar)[XB_TMO], 1u); break; } } } } while (0)
struct XcdBarrier { unsigned* bar; unsigned x; volatile LAS unsigned* st; };
__device__ __forceinline__ XcdBarrier xcd_barrier_post(unsigned* bar, volatile LAS unsigned* st) {
    XcdBarrier b; b.bar = bar; b.x = xb_xcc_id(); b.st = st;
    if (threadIdx.x == 0) (void)xb_add(&bar[XB_XCNT(b.x)], 1u);
    return b;
}
__device__ __forceinline__ void xcd_barrier_complete(unsigned* bar, unsigned x, unsigned& nloc, unsigned& nx) {
    const unsigned G = gridDim.x * gridDim.y * gridDim.z;
    unsigned sum, cnt, mine, sp = 0u;
    for (;;) {
        sum = 0u; cnt = 0u; mine = 0u;
#pragma unroll
        for (unsigned j = 0; j < 16; ++j) { const unsigned c = xb_ld(&bar[XB_XCNT(j)]); sum += c; cnt += (c > 0u) ? 1u : 0u; mine = (j == x) ? c : mine; }
        if (sum == G) break;
        __builtin_amdgcn_s_sleep(1);
        if ((++sp & 255u) == 0u) { if (xb_ld(&bar[XB_TMO])) break; if (sp > XB_SPIN_CAP) { atomicAdd(&bar[XB_TMO], 1u); break; } }
    }
    nloc = mine > 0u ? mine : 1u; nx = cnt > 0u ? cnt : 1u;
}
__device__ __forceinline__ void xcd_barrier(const XcdBarrier& b) {
    asm volatile("s_waitcnt vmcnt(0)" ::: "memory");
    __syncthreads();
    if (threadIdx.x == 0) {
        unsigned* bar = b.bar;
        __builtin_amdgcn_s_waitcnt(0);
        unsigned nloc = b.st[0], nx = b.st[1];
        if (nloc == 0u) { xcd_barrier_complete(bar, b.x, nloc, nx); b.st[0] = nloc; b.st[1] = nx; }
        const unsigned old = xb_add(&bar[XB_XSUB(b.x)], 1u);
        const unsigned gen = old / nloc;
        if (old + 1u == (gen + 1u) * nloc) {
            __builtin_amdgcn_fence(__ATOMIC_RELEASE, "agent");
            asm volatile("s_waitcnt vmcnt(0)" ::: "memory");
            const unsigned og = xb_add(&bar[XB_TOP], 1u);
            const unsigned tg = og / nx;
            if (og + 1u == (tg + 1u) * nx) xb_add(&bar[XB_TOPGEN], 1u);
            else XB_SPIN(xb_ld(&bar[XB_TOPGEN]) == tg, bar);
            __builtin_amdgcn_fence(__ATOMIC_ACQUIRE, "agent");
            xb_add(&bar[XB_XGEN(b.x)], 1u);
            asm volatile("s_waitcnt vmcnt(0)" ::: "memory");
        } else {
            XB_SPIN(xb_ld(&bar[XB_XGEN(b.x)]) == gen, bar);
            __builtin_amdgcn_fence(__ATOMIC_ACQUIRE, "agent");
            asm volatile("s_waitcnt vmcnt(0)" ::: "memory");
        }
    }
    __syncthreads();
}

namespace att {
constexpr int KVBLK = 64, LDQ = INW, LDK = INW;
constexpr int SHM_V = KVBLK * 128 * 2, SHM_K = KVBLK * 128 * 2, WS_OFF = 2 * SHM_V + 2 * SHM_K, OST_OFF = WS_OFF + 8 * 64 * 4, OST_STRIDE = 272, OST_WAVE = 32 * OST_STRIDE, LDS_NEED = OST_OFF + 8 * OST_WAVE;
static_assert(LDS_NEED <= RING_BYTES, "attention LDS");
#define KSWZ(row, colB) ((row) * 256 + ((colB) ^ (((row) & 7) << 4)))
#define SBAR() __builtin_amdgcn_sched_barrier(0)
__device__ __forceinline__ int crow(int r, int hi) { return (r & 3) + 8 * (r >> 2) + 4 * hi; }
__device__ __forceinline__ unsigned cvtpk(float lo, float hi) { unsigned r; asm volatile("v_cvt_pk_bf16_f32 %0, %1, %2" : "=v"(r) : "v"(lo), "v"(hi)); return r; }
constexpr float THR = 8.f;
template <int MODE> struct Cfg { static constexpr float SCALE = (MODE == 1) ? 0.125f : 0.088388347648318440f; static constexpr int ND0 = (MODE == 1) ? 4 : 8; };

template <int MODE> __device__ __forceinline__ void partialSM(f32x16& p0, f32x16& p1, float& m_reg, float& mn, float& alpha) {
  constexpr float SC = Cfg<MODE>::SCALE, C = SC * 1.4426950408889634f;
  float pmax = p0[0]; for (int r = 1; r < 16; ++r) pmax = fmaxf(pmax, p0[r]); for (int r = 0; r < 16; ++r) pmax = fmaxf(pmax, p1[r]);
  { auto rr = __builtin_amdgcn_permlane32_swap(__float_as_uint(pmax), __float_as_uint(pmax), false, false);
    pmax = fmaxf(__uint_as_float(rr[0]), __uint_as_float(rr[1])); }
  if (__builtin_expect(__all(pmax - m_reg <= THR / SC), 1)) { mn = m_reg; alpha = 1.f; }
  else { mn = fmaxf(m_reg, pmax); alpha = __builtin_amdgcn_exp2f((m_reg - mn) * C); m_reg = mn; }
  float mnC = -mn * C;
  for (int r = 0; r < 16; ++r) p0[r] = fmaf(p0[r], C, mnC); for (int r = 0; r < 16; ++r) p1[r] = fmaf(p1[r], C, mnC);
  for (int r = 0; r < 16; ++r) p0[r] = __builtin_amdgcn_exp2f(p0[r]);
}
__device__ __forceinline__ void finishSM(f32x16& p0, f32x16& p1, float alpha, float& l_reg, bf16x8& pa0, bf16x8& pa1, bf16x8& pa2, bf16x8& pa3) {
  for (int r = 0; r < 16; ++r) p1[r] = __builtin_amdgcn_exp2f(p1[r]);
  float ps = 0; for (int r = 0; r < 16; ++r) ps += p0[r]; for (int r = 0; r < 16; ++r) ps += p1[r];
  { auto rr = __builtin_amdgcn_permlane32_swap(__float_as_uint(ps), __float_as_uint(ps), false, false);
    ps = __uint_as_float(rr[0]) + __uint_as_float(rr[1]); }
  l_reg = l_reg * alpha + ps;
#define PK4(P, BASE, OUT) do { unsigned a0 = cvtpk(P[BASE + 0], P[BASE + 1]), a1 = cvtpk(P[BASE + 2], P[BASE + 3]);   \
    unsigned b0 = cvtpk(P[BASE + 4], P[BASE + 5]), b1 = cvtpk(P[BASE + 6], P[BASE + 7]);                              \
    auto r0 = __builtin_amdgcn_permlane32_swap(a0, b0, false, false); auto r1 = __builtin_amdgcn_permlane32_swap(a1, b1, false, false); \
    v4u w = {r0[0], r1[0], r0[1], r1[1]}; OUT = *reinterpret_cast<bf16x8*>(&w); } while (0)
  PK4(p0, 0, pa0); PK4(p0, 8, pa1); PK4(p1, 0, pa2); PK4(p1, 8, pa3);
#undef PK4
}
template <int MODE> __device__ __forceinline__ void qkt(f32x16& p0, f32x16& p1, const char* Ks, const bf16x8* qr, int r32, int hi, const float* bias, int lane) {
  if constexpr (MODE == 2) {
    const f32x4* bp = (const f32x4*)bias + lane;
#pragma unroll
    for (int g = 0; g < 4; ++g) { const f32x4 a = bp[g * 64], b = bp[(4 + g) * 64];
#pragma unroll
      for (int j = 0; j < 4; ++j) { p0[4 * g + j] = a[j]; p1[4 * g + j] = b[j]; } }
  } else { p0 = f32x16{}; p1 = f32x16{}; }
#pragma unroll
  for (int d0 = 0; d0 < Cfg<MODE>::ND0; ++d0) { int cb = (d0 * 16 + hi * 8) * 2;
    bf16x8 b0 = *reinterpret_cast<const bf16x8*>(Ks + KSWZ(r32, cb));
    bf16x8 b1 = *reinterpret_cast<const bf16x8*>(Ks + KSWZ(32 + r32, cb));
    p0 = __builtin_amdgcn_mfma_f32_32x32x16_bf16(b0, qr[d0], p0, 0, 0, 0);
    p1 = __builtin_amdgcn_mfma_f32_32x32x16_bf16(b1, qr[d0], p1, 0, 0, 0); }
}
__device__ __forceinline__ int v_st(int k, int c) { const int kk = (k & ~0xC) | ((k & 4) << 1) | ((k & 8) >> 1); return ((kk >> 3) * 4 + (c >> 5)) * 512 + ((kk & 7) * 32 + (c & 31)) * 2; }
__device__ __forceinline__ int v_rd_base(int lane) { return ((lane & 3) << 3) | (((lane >> 2) & 3) << 6) | (((lane >> 4) & 1) << 5) | (((lane >> 5) & 1) << 8); }
constexpr int v_rd_off(int d0, int ks, int half) { return d0 * 512 + ks * 4096 + half * 2048; }
template <int OFF> __device__ __forceinline__ s16x4 tr_read(int vb) {
  s16x4 r; asm volatile("ds_read_b64_tr_b16 %0, %1 offset:%2" : "=&v"(r) : "v"(vb), "i"(OFF) : "memory"); return r;
}
template <int D0> __device__ __forceinline__ void pv_one(f32x16& od, int vb, bf16x8 pa0, bf16x8 pa1, bf16x8 pa2, bf16x8 pa3) {
  const s16x4 l0 = tr_read<v_rd_off(D0, 0, 0)>(vb), h0 = tr_read<v_rd_off(D0, 0, 1)>(vb), l1 = tr_read<v_rd_off(D0, 1, 0)>(vb), h1 = tr_read<v_rd_off(D0, 1, 1)>(vb);
  const s16x4 l2 = tr_read<v_rd_off(D0, 2, 0)>(vb), h2 = tr_read<v_rd_off(D0, 2, 1)>(vb), l3 = tr_read<v_rd_off(D0, 3, 0)>(vb), h3 = tr_read<v_rd_off(D0, 3, 1)>(vb);
  asm volatile("s_waitcnt lgkmcnt(0)" ::: "memory"); SBAR();
#define PK(L, H) (bf16x8){L[0], L[1], L[2], L[3], H[0], H[1], H[2], H[3]}
  od = __builtin_amdgcn_mfma_f32_32x32x16_bf16(pa0, PK(l0, h0), od, 0, 0, 0);
  od = __builtin_amdgcn_mfma_f32_32x32x16_bf16(pa1, PK(l1, h1), od, 0, 0, 0);
  od = __builtin_amdgcn_mfma_f32_32x32x16_bf16(pa2, PK(l2, h2), od, 0, 0, 0);
  od = __builtin_amdgcn_mfma_f32_32x32x16_bf16(pa3, PK(l3, h3), od, 0, 0, 0);
#undef PK
}
__device__ __forceinline__ void pv_d0(f32x16* o, int vb, bf16x8 pa0, bf16x8 pa1, bf16x8 pa2, bf16x8 pa3) {
  pv_one<0>(o[0], vb, pa0, pa1, pa2, pa3); pv_one<1>(o[1], vb, pa0, pa1, pa2, pa3); pv_one<2>(o[2], vb, pa0, pa1, pa2, pa3); pv_one<3>(o[3], vb, pa0, pa1, pa2, pa3);
}

struct Tiles {
  int NT;
  int jmax;
  int jsplit, extra;
  const float* btab;
  const float* bmask; const float* bzero;
  int rlo, nrows, Rw, r0w, half;
  __device__ __forceinline__ int krow(int j) const { const int je = j < jmax ? j : jmax; return je * 64 + (je >= jsplit ? extra : 0); }
  __device__ __forceinline__ const float* bias(int j) const {
    if (j < 4) return bzero;
    const int i = j - 4, rr = rlo + i; const bool in = (i < nrows) && (rr >= r0w) && (rr < r0w + 8);
    return in ? btab + (size_t)((rr - Rw + 7) * 2 + half) * 2048 : bmask;
  }
};

template <int MODE>
__device__ __forceinline__ void attn_core(const bf16* Pb, unsigned qoff, unsigned koff, unsigned voff, const Tiles& T, int kcolB, char* lds, f32x16 (&o)[4]) {
  const int tid = opaque_tid(), wid = __builtin_amdgcn_readfirstlane(tid >> 6), lane = tid & 63, r32 = lane & 31, hi = lane >> 5;
  char* V_lds = lds; char* K_lds = lds + 2 * SHM_V;
  float* ws = (float*)(lds + WS_OFF) + wid * 64; float* li_l = ws; float* al_l = ws + 32;
  float m_reg = -1e30f, l_reg = 0; bf16x8 qr[Cfg<MODE>::ND0];
#pragma unroll
  for (int d = 0; d < 4; ++d) o[d] = f32x16{};
  const __amdgpu_buffer_rsrc_t rsrc = __builtin_amdgcn_make_buffer_rsrc((void*)Pb, 0, (int)((size_t)M * INW * 2), 0x00020000);
  { const unsigned qv = (unsigned)((wid * 32 + r32) * LDQ + hi * 8) * 2u, qs = __builtin_amdgcn_readfirstlane(qoff * 2u);
#pragma unroll
    for (int d0 = 0; d0 < Cfg<MODE>::ND0; ++d0) { const v4u w = __builtin_amdgcn_raw_buffer_load_b128(rsrc, qv + d0 * 32, qs, 0); qr[d0] = *reinterpret_cast<const bf16x8*>(&w); } }
  const int sr = tid >> 4, sc = (tid & 15) * 8, vst0 = v_st(sr, sc), vst1 = v_st(32 + sr, sc);
  const unsigned kvv = (unsigned)(sr * LDK + sc) * 2u;
  const int vb0 = (int)(uintptr_t)V_lds + v_rd_base(lane);
  struct { bf16x8 vs0, vs1, ks0, ks1; } sr_[2];
#define SLOAD(i, j) do { const unsigned k0_ = (unsigned)T.krow(j) * (unsigned)(LDK * 2), vs_ = __builtin_amdgcn_readfirstlane(voff * 2u + k0_), ks_ = __builtin_amdgcn_readfirstlane(koff * 2u + k0_); \
    v4u t0_ = __builtin_amdgcn_raw_buffer_load_b128(rsrc, kvv, vs_, 0), t1_ = __builtin_amdgcn_raw_buffer_load_b128(rsrc, kvv, vs_ + 32u * LDK * 2u, 0); \
    v4u t2_ = __builtin_amdgcn_raw_buffer_load_b128(rsrc, kvv, ks_, 0), t3_ = __builtin_amdgcn_raw_buffer_load_b128(rsrc, kvv, ks_ + 32u * LDK * 2u, 0); \
    sr_[i].vs0 = *reinterpret_cast<bf16x8*>(&t0_); sr_[i].vs1 = *reinterpret_cast<bf16x8*>(&t1_); sr_[i].ks0 = *reinterpret_cast<bf16x8*>(&t2_); sr_[i].ks1 = *reinterpret_cast<bf16x8*>(&t3_); } while (0)
#define SWRITE(b, i) do { *(bf16x8*)(V_lds + (b) * SHM_V + vst0) = sr_[i].vs0;          \
    *(bf16x8*)(V_lds + (b) * SHM_V + vst1) = sr_[i].vs1; int kc = sc * 2;               \
    *(bf16x8*)(K_lds + (b) * SHM_K + KSWZ(sr, kc)) = sr_[i].ks0;                       \
    *(bf16x8*)(K_lds + (b) * SHM_K + KSWZ(32 + sr, kc)) = sr_[i].ks1; } while (0)
#define SWAIT() asm volatile("s_waitcnt vmcnt(4)" ::: "memory")
#define RESC(a) do { if (__any((a) < 1.f)) { if (hi == 0) al_l[r32] = (a); asm volatile("s_waitcnt lgkmcnt(0)" ::: "memory"); \
    for (int d = 0; d < 4; ++d) for (int r = 0; r < 16; ++r) o[d][r] *= al_l[crow(r, hi)]; } } while (0)
  f32x16 pA0, pA1, pB0, pB1; float mnA, mnB, alA, alB; bf16x8 pa0, pa1, pa2, pa3; const int NT = T.NT;
  const char* K0 = K_lds + kcolB; const char* K1 = K_lds + SHM_K + kcolB;
  constexpr int SE = 0, SO = 1;
  SLOAD(SE, 0); asm volatile("s_waitcnt vmcnt(0)" ::: "memory"); SWRITE(0, SE); __syncthreads();
  qkt<MODE>(pA0, pA1, K0, qr, r32, hi, MODE == 2 ? T.bias(0) : nullptr, lane); partialSM<MODE>(pA0, pA1, m_reg, mnA, alA);
  SLOAD(SO, 1); if (2 < NT) SLOAD(SE, 2);
  SWAIT(); SWRITE(1, SO); __syncthreads();
  for (int j = 1; j + 1 < NT; j += 2) {
    SBAR(); qkt<MODE>(pB0, pB1, K1, qr, r32, hi, MODE == 2 ? T.bias(j) : nullptr, lane);
    finishSM(pA0, pA1, alA, l_reg, pa0, pa1, pa2, pa3); SBAR();
    SLOAD(SO, j + 2); SBAR();
    pv_d0(o, vb0, pa0, pa1, pa2, pa3); partialSM<MODE>(pB0, pB1, m_reg, mnB, alB);
    __syncthreads(); SWAIT(); SWRITE(0, SE);
    RESC(alB); __syncthreads();
    SBAR(); qkt<MODE>(pA0, pA1, K0, qr, r32, hi, MODE == 2 ? T.bias(j + 1) : nullptr, lane);
    finishSM(pB0, pB1, alB, l_reg, pa0, pa1, pa2, pa3); SBAR();
    if (j + 3 < NT) SLOAD(SE, j + 3); SBAR();
    pv_d0(o, vb0 + (int)SHM_V, pa0, pa1, pa2, pa3); partialSM<MODE>(pA0, pA1, m_reg, mnA, alA);
    __syncthreads(); SWAIT(); SWRITE(1, SO);
    RESC(alA); __syncthreads();
  }
  SBAR(); qkt<MODE>(pB0, pB1, K1, qr, r32, hi, MODE == 2 ? T.bias(NT - 1) : nullptr, lane);
  finishSM(pA0, pA1, alA, l_reg, pa0, pa1, pa2, pa3); SBAR();
  pv_d0(o, vb0, pa0, pa1, pa2, pa3); partialSM<MODE>(pB0, pB1, m_reg, mnB, alB);
  __syncthreads(); RESC(alB);
  finishSM(pB0, pB1, alB, l_reg, pa0, pa1, pa2, pa3); SBAR();
  pv_d0(o, vb0 + (int)SHM_V, pa0, pa1, pa2, pa3);
  if (hi == 0) li_l[r32] = l_reg; asm volatile("s_waitcnt lgkmcnt(0)" ::: "memory");
#pragma unroll
  for (int r = 0; r < 16; ++r) { const float rl = __builtin_amdgcn_rcpf(li_l[crow(r, hi)]);
#pragma unroll
    for (int d0 = 0; d0 < 4; ++d0) o[d0][r] *= rl; }
  __syncthreads();
#undef SLOAD
#undef SWRITE
#undef SWAIT
#undef RESC
}
__device__ __forceinline__ void store_o_bf16(const f32x16 (&o)[4], bf16* Ob, char* lds) {
  const int tid = opaque_tid(), wid = __builtin_amdgcn_readfirstlane(tid >> 6), lane = tid & 63, r32 = lane & 31, hi = lane >> 5;
  char* st = lds + OST_OFF + wid * OST_WAVE;
#pragma unroll
  for (int r = 0; r < 16; ++r) { const int row = crow(r, hi);
#pragma unroll
    for (int d0 = 0; d0 < 4; ++d0) *(unsigned short*)(st + row * OST_STRIDE + (d0 * 32 + r32) * 2) = (unsigned short)f2bf(o[d0][r]); }
  asm volatile("s_waitcnt lgkmcnt(0)" ::: "memory");
#pragma unroll
  for (int i = 0; i < 8; ++i) { const int row = i * 4 + (lane >> 4), ch = lane & 15;
    const v4u w = *(const v4u*)(st + row * OST_STRIDE + ch * 16);
    *(v4u*)(Ob + (size_t)(wid * 32 + row) * D + ch * 8) = w; }
  asm volatile("s_waitcnt lgkmcnt(0)" ::: "memory");
}
#undef KSWZ
}

struct Args { const float* in[26]; float* out; unsigned char* ws; int ph_lo, ph_hi, li, pad; };
enum { I_X = 0, I_C, I_CTX, I_CCTX, I_ADOWN, I_AUP, I_ABIAS, I_NMPRE, I_NMPOST, I_NFPRE, I_NFPOST, I_WIN, I_AQN, I_AKN, I_RPB, I_LQ1, I_LK1, I_LQ2, I_LK2, I_SUBLN, I_WGU, I_BGATE, I_WBR, I_WOUT, I_WFFI, I_WFFO };

__device__ __forceinline__ const float* inp(int i) { asm volatile("" : "+s"(i)); return ((const float* const*)__builtin_amdgcn_kernarg_segment_ptr())[i]; }
__device__ __forceinline__ float* outp() { int i = 26; asm volatile("" : "+s"(i)); return ((float* const*)__builtin_amdgcn_kernarg_segment_ptr())[i]; }
struct Frame {
    LAS unsigned char* lds; unsigned char* ws; int vcu, G;
};

__device__ __forceinline__ void transpose_item(const float* W, int K, int N, bf16* Bt, int k0, int n0, int r0, LAS float* scr, int lane) {
    const float* src = W + (size_t)k0 * N + n0 + (lane & 15) * 4;
#pragma unroll 4
    for (int i = 0; i < 16; ++i) { const int kk = 4 * i + (lane >> 4); const f32x4 v = *(const f32x4*)(src + (size_t)kk * N);
        LAS float* d = scr + kk * 65 + (lane & 15) * 4; d[0] = v[0]; d[1] = v[1]; d[2] = v[2]; d[3] = v[3]; }
    asm volatile("s_waitcnt lgkmcnt(0)" ::: "memory");
    const int c = lane & 7;
#pragma unroll
    for (int j = 0; j < 8; ++j) { const int n = (lane >> 3) + 8 * j; const LAS float* s = scr + (8 * c) * 65 + n;
        v4u o; o.x = pk2(s[0 * 65], s[1 * 65]); o.y = pk2(s[2 * 65], s[3 * 65]); o.z = pk2(s[4 * 65], s[5 * 65]); o.w = pk2(s[6 * 65], s[7 * 65]);
        *(v4u*)(Bt + (size_t)(r0 + n) * K + k0 + 8 * c) = o; }
    asm volatile("s_waitcnt lgkmcnt(0)" ::: "memory");
}
__device__ __forceinline__ void phase_p0(const Frame& F, const Args& A) {
    const int tid_ = opaque_tid(), lane_ = tid_ & 63, wave_ = __builtin_amdgcn_readfirstlane(tid_ >> 6); (void)tid_; (void)lane_; (void)wave_;
    const int gw = F.vcu * 8 + wave_, NGW = F.G * 8;
    for (int it = gw; it < 256; it += NGW) {
        const int l = it >> 6, jb = (it >> 4) & 3, kc = it & 15, j = jb * 64 + lane_;
        const float* wd = inp(I_ADOWN) + (size_t)l * D * ADAR; float acc[5] = {0.f, 0.f, 0.f, 0.f, 0.f};
        for (int k = kc * 256; k < kc * 256 + 256; ++k) { const float w = wd[(size_t)k * ADAR + j];
#pragma unroll
            for (int r = 0; r < 5; ++r) { const float cv = (r < 4) ? inp(I_C)[r * D + k] : inp(I_CCTX)[k]; acc[r] += cv * pg8::sigm(cv) * w; } }
        float* t1p = (float*)(F.ws + WS_T1P);
#pragma unroll
        for (int r = 0; r < 5; ++r) t1p[((l * 16 + kc) * 5 + r) * 256 + j] = acc[r];
    }
    LAS float* scr = (LAS float*)(F.lds + wave_ * 16640);
    constexpr int I0 = (D / 64) * (INW / 64), I1 = (GRK / 64) * (3 * D / 64), I2 = (D / 64) * (D / 64), I3 = I2, I4 = (D / 64) * (2 * DFF / 64), I5 = (DFF / 64) * (D / 64), IL = I0 + I1 + I2 + I3 + I4 + I5;
    for (int it = gw; it < DEPTH * IL; it += NGW) {
        const int l = it / IL; int r = it % IL; unsigned char* wb = F.ws + WS_W + (size_t)l * W_LAYER;
        if (r < I0) { const int nb = INW / 64; transpose_item(inp(I_WIN) + (size_t)l * D * INW, D, INW, (bf16*)(wb + W_IN), (r / nb) * 64, (r % nb) * 64, (r % nb) * 64, scr, lane_); continue; } r -= I0;
        if (r < I1) { const int nb = 3 * D / 64; transpose_item(inp(I_WGU) + (size_t)l * GRK * 3 * D, GRK, 3 * D, (bf16*)(wb + W_GATE), (r / nb) * 64, (r % nb) * 64, (r % nb) * 64, scr, lane_); continue; } r -= I1;
        if (r < I2) { const int nb = D / 64; transpose_item(inp(I_WBR) + (size_t)l * D * D, D, D, (bf16*)(wb + W_BR), (r / nb) * 64, (r % nb) * 64, (r % nb) * 64, scr, lane_); continue; } r -= I2;
        if (r < I3) { const int nb = D / 64; transpose_item(inp(I_WOUT) + (size_t)l * D * D, D, D, (bf16*)(wb + W_OUT), (r / nb) * 64, (r % nb) * 64, (r % nb) * 64, scr, lane_); continue; } r -= I3;
        if (r < I4) { const int nb = 2 * DFF / 64; const int n0 = (r % nb) * 64, hf = n0 / DFF, cc = n0 % DFF, r0 = (cc / 128) * 256 + hf * 128 + (cc % 128);
            transpose_item(inp(I_WFFI) + (size_t)l * D * 2 * DFF, D, 2 * DFF, (bf16*)(wb + W_FFI), (r / nb) * 64, n0, r0, scr, lane_); continue; } r -= I4;
        { const int nb = D / 64; transpose_item(inp(I_WFFO) + (size_t)l * DFF * D, DFF, D, (bf16*)(wb + W_FFO), (r / nb) * 64, (r % nb) * 64, (r % nb) * 64, scr, lane_); }
    }
}
__device__ __forceinline__ void phase_p1(const Frame& F, const Args& A) {
    const int tid_ = opaque_tid(), lane_ = tid_ & 63, wave_ = __builtin_amdgcn_readfirstlane(tid_ >> 6); (void)tid_; (void)lane_; (void)wave_;
    const int gw = F.vcu * 8 + wave_, NGW = F.G * 8;
    LAS float* tl = (LAS float*)(F.lds + wave_ * 8192);
    for (int it = gw; it < DEPTH * 96; it += NGW) {
        const int l = it / 96, nb = it % 96, n4 = nb * 256 + lane_ * 4;
        const float* t1p = (const float*)(F.ws + WS_T1P);
#pragma unroll
        for (int q = 0; q < 4; ++q)
#pragma unroll
            for (int r = 0; r < 5; ++r) { const int j = lane_ + 64 * q; float s = 0.f;
                for (int kc = 0; kc < 16; ++kc) s += __hip_atomic_load(t1p + ((l * 16 + kc) * 5 + r) * 256 + j, RLX_AGENT);
                tl[r * 256 + j] = s; }
        asm volatile("s_waitcnt lgkmcnt(0)" ::: "memory");
        const float* wu = inp(I_AUP) + (size_t)l * ADAR * 6 * D + n4;
        f32x4 acc[5];
#pragma unroll
        for (int r = 0; r < 5; ++r) acc[r] = (f32x4){0.f, 0.f, 0.f, 0.f};
#pragma unroll 4
        for (int j = 0; j < ADAR; ++j) { const f32x4 w = *(const f32x4*)(wu + (size_t)j * 6 * D);
#pragma unroll
            for (int r = 0; r < 5; ++r) acc[r] += w * tl[r * 256 + j]; }
        const f32x4 bv = *(const f32x4*)(inp(I_ABIAS) + (size_t)l * 6 * D + n4);
        float* mod = (float*)(F.ws + WS_MOD);
#pragma unroll
        for (int r = 0; r < 5; ++r) *(f32x4*)(mod + ((size_t)l * 5 + r) * 6 * D + n4) = acc[r] + bv;
        asm volatile("s_waitcnt lgkmcnt(0)" ::: "memory");
    }
    const int gt = F.vcu * 512 + tid_, NGT = F.G * 512;
    for (int e = gt; e < 64 * 32 + 64 * 16; e += NGT) {
        float* rp = (float*)(F.ws + WS_ROPE);
        if (e < 2048) { const int pos = e >> 5, i = e & 31; const double a = (double)pos * exp(-9.210340371976184 * (double)i / 32.0); rp[e] = (float)cos(a); rp[2048 + e] = (float)sin(a); }
        else { const int e2 = e - 2048, pos = e2 >> 4, i = e2 & 15; const double a = (double)pos * exp(-9.210340371976184 * (double)i / 16.0); rp[4096 + e2] = (float)cos(a); rp[4096 + 1024 + e2] = (float)sin(a); }
    }
    for (int e = gt; e < 4 * 8 * 15 * 2 * 2048; e += NGT) {
        const int j = e & 3, ln = (e >> 2) & 63, g = (e >> 8) & 7, half = (e >> 11) & 1, rest = e >> 12, dr = rest % 15, lh = rest / 15;
        const int qc = half * 32 + (ln & 31), hi = ln >> 5, kc = ((g < 4) ? 0 : 32) + j + 8 * (g & 3) + 4 * hi;
        int c0 = qc - 8; c0 = c0 < 0 ? 0 : (c0 > 48 ? 48 : c0);
        const bool valid = (kc >= c0) && (kc < c0 + 16);
        int idx = kc - qc + 15; idx = idx < 0 ? 0 : (idx > 30 ? 30 : idx);
        const float v = valid ? inp(I_RPB)[((size_t)lh * 15 + dr) * 31 + idx] * 11.313708498984761f : -1e30f;
        ((float*)(F.ws + WS_BIAS))[e] = v;
    }
    for (int e = gt; e < 4096; e += NGT) ((float*)(F.ws + WS_BMASK))[e] = (e < 2048) ? -1e30f : 0.f;
    if (gw == 0) {
        for (int l = 0; l < DEPTH; ++l) {
            const float a = wave_sum(inp(I_LQ1)[l * 64 + lane_] * inp(I_LK1)[l * 64 + lane_]), b = wave_sum(inp(I_LQ2)[l * 64 + lane_] * inp(I_LK2)[l * 64 + lane_]);
            const float lam_init = 0.8f - 0.6f * expf(-0.3f * (float)l);
            if (lane_ == 0) ((float*)(F.ws + WS_LAM))[l] = expf(a) - expf(b) + lam_init;
        }
    }
}
template <int MODE>
__device__ __forceinline__ void phase_rows(const Frame& F, const Args& A, const float* gpost, const float* modA  , const float* gpre, const float* modSh, const float* modSc) {
    const int tid_ = opaque_tid(), lane_ = tid_ & 63, wave_ = __builtin_amdgcn_readfirstlane(tid_ >> 6); (void)tid_; (void)lane_; (void)wave_;
    const int gw = F.vcu * 8 + wave_, NGW = F.G * 8;
    float* X = (float*)(F.ws + WS_X); const float* Y = (const float*)(F.ws + WS_Y); bf16* H = (bf16*)(F.ws + WS_H);
    for (int m = gw; m < M; m += NGW) {
        const int b = m / TPB, i = m % TPB, mr = (i < CTXL) ? 4 : b; const size_t mo = (size_t)mr * 6 * D;
        f32x4 x[16];
        float* xr = X + (size_t)m * D + lane_ * 4;
        if constexpr (MODE == 0) {
            const float* src = (i < CTXL) ? inp(I_CTX) + ((size_t)b * CTXL + i) * D : inp(I_X) + ((size_t)b * SEQ + (i - CTXL)) * D;
#pragma unroll
            for (int q = 0; q < 16; ++q) { x[q] = *(const f32x4*)(src + lane_ * 4 + q * 256); *(f32x4*)(xr + q * 256) = x[q]; }
        } else {
            f32x4 y[16]; float ss = 0.f; const float* yr = Y + (size_t)m * D + lane_ * 4;
#pragma unroll
            for (int q = 0; q < 16; ++q) { y[q] = *(const f32x4*)(yr + q * 256); x[q] = *(const f32x4*)(xr + q * 256); ss += (y[q][0] * y[q][0] + y[q][1] * y[q][1]) + (y[q][2] * y[q][2] + y[q][3] * y[q][3]); }
            const float rs = 1.0f / sqrtf(wave_sum(ss) * (1.0f / D) + EPS);
#pragma unroll
            for (int q = 0; q < 16; ++q) { const f32x4 gp = *(const f32x4*)(gpost + lane_ * 4 + q * 256), ga = *(const f32x4*)(modA + mo + lane_ * 4 + q * 256);
                x[q] = x[q] + ga * ((y[q] * rs) * gp); }
            if constexpr (MODE == 2) {
                if (i >= CTXL) { float* orow = outp() + ((size_t)b * SEQ + (i - CTXL)) * D + lane_ * 4;
#pragma unroll
                    for (int q = 0; q < 16; ++q) *(f32x4*)(orow + q * 256) = x[q]; }
            } else {
#pragma unroll
                for (int q = 0; q < 16; ++q) *(f32x4*)(xr + q * 256) = x[q];
            }
        }
        if constexpr (MODE != 2) {
            float ss = 0.f;
#pragma unroll
            for (int q = 0; q < 16; ++q) ss += (x[q][0] * x[q][0] + x[q][1] * x[q][1]) + (x[q][2] * x[q][2] + x[q][3] * x[q][3]);
            const float rs = 1.0f / sqrtf(wave_sum(ss) * (1.0f / D) + EPS);
            bf16* hr = H + (size_t)m * D + lane_ * 4;
#pragma unroll
            for (int q = 0; q < 16; ++q) { const f32x4 g = *(const f32x4*)(gpre + lane_ * 4 + q * 256), sc = *(const f32x4*)(modSc + mo + lane_ * 4 + q * 256), sh = *(const f32x4*)(modSh + mo + lane_ * 4 + q * 256);
                const f32x4 h = ((x[q] * rs) * g) * (1.0f + sc) + sh;
                v2u w; w.x = pk2(h[0], h[1]); w.y = pk2(h[2], h[3]); *(v2u*)(hr + q * 256) = w; }
        }
    }
}
__device__ __forceinline__ void phase_qk(const Frame& F, const Args& A, int l) {
    const int tid_ = opaque_tid(), lane_ = tid_ & 63, wave_ = __builtin_amdgcn_readfirstlane(tid_ >> 6); (void)tid_; (void)lane_; (void)wave_;
    const int gw = F.vcu * 8 + wave_, NGW = F.G * 8;
    bf16* P = (bf16*)(F.ws + WS_PROJ); const float* rp = (const float*)(F.ws + WS_ROPE);
    const float* gq = inp(I_AQN) + l * HD; const float* gk = inp(I_AKN) + l * HD;
    for (int m = gw; m < M; m += NGW) {
        const int i = m % TPB; const bool lat = i >= CTXL; const int t = i - CTXL, prow = t >> 6, pcol = t & 63;
        bf16* row = P + (size_t)m * INW;
#pragma unroll
        for (int s = 0; s < 5; ++s) {
            const int col = s * 512 + lane_ * 8, d = col & 127;
            v4u w = *(const v4u*)(row + col);
            float v[8] = {bflo(w.x), bfhi(w.x), bflo(w.y), bfhi(w.y), bflo(w.z), bfhi(w.z), bflo(w.w), bfhi(w.w)};
            float ss = 0.f;
#pragma unroll
            for (int j = 0; j < 8; ++j) ss += v[j] * v[j];
            ss += __shfl_xor(ss, 1); ss += __shfl_xor(ss, 2); ss += __shfl_xor(ss, 4); ss += __shfl_xor(ss, 8);
            const float rs = 1.0f / sqrtf(ss * (1.0f / HD) + EPS);
            const float* g = (col < C_AK) ? gq : gk;
            const f32x4 g0 = *(const f32x4*)(g + d), g1 = *(const f32x4*)(g + d + 4);
#pragma unroll
            for (int j = 0; j < 4; ++j) { v[j] = v[j] * rs * g0[j]; v[4 + j] = v[4 + j] * rs * g1[j]; }
            if (lat) {
                const int p0 = d >> 1; const int pos = (p0 < 32) ? prow : pcol; const int fi = p0 & 31;
                const f32x4 cs = *(const f32x4*)(rp + pos * 32 + fi), sn = *(const f32x4*)(rp + 2048 + pos * 32 + fi);
#pragma unroll
                for (int j = 0; j < 4; ++j) { const float a = v[2 * j], b2 = v[2 * j + 1]; v[2 * j] = a * cs[j] - b2 * sn[j]; v[2 * j + 1] = a * sn[j] + b2 * cs[j]; }
            }
            w.x = pk2(v[0], v[1]); w.y = pk2(v[2], v[3]); w.z = pk2(v[4], v[5]); w.w = pk2(v[6], v[7]);
            *(v4u*)(row + col) = w;
        }
        if (lat) {
#pragma unroll
            for (int s = 0; s < 4; ++s) {
                const int col = C_CQ + s * 512 + lane_ * 8, d = col & 63;
                v4u w = *(const v4u*)(row + col);
                float v[8] = {bflo(w.x), bfhi(w.x), bflo(w.y), bfhi(w.y), bflo(w.z), bfhi(w.z), bflo(w.w), bfhi(w.w)};
                const int p0 = d >> 1; const int pos = (p0 < 16) ? prow : pcol; const int fi = p0 & 15;
                const f32x4 cs = *(const f32x4*)(rp + 4096 + pos * 16 + fi), sn = *(const f32x4*)(rp + 4096 + 1024 + pos * 16 + fi);
#pragma unroll
                for (int j = 0; j < 4; ++j) { const float a = v[2 * j], b2 = v[2 * j + 1]; v[2 * j] = a * cs[j] - b2 * sn[j]; v[2 * j + 1] = a * sn[j] + b2 * cs[j]; }
                w.x = pk2(v[0], v[1]); w.y = pk2(v[2], v[3]); w.z = pk2(v[4], v[5]); w.w = pk2(v[6], v[7]);
                *(v4u*)(row + col) = w;
            }
        }
    }
}
__device__ __forceinline__ void phase_attn(const Frame& F, const Args& A, int l) {
    const int tid_ = opaque_tid(), lane_ = tid_ & 63, wave_ = __builtin_amdgcn_readfirstlane(tid_ >> 6); (void)tid_; (void)lane_; (void)wave_;
    char* lds = (char*)F.lds;
    const bf16* P = (const bf16*)(F.ws + WS_PROJ); bf16* MIX = (bf16*)(F.ws + WS_MIX);
    const bool last = (l == DEPTH - 1);
    if (PHM & 0x1000) {
        const int nU = 1024 + (last ? 0 : 96);
        for (int u = F.vcu; u < nU; u += F.G) {
            int b, qrow, kcol, vcol, qcol, ocol, nt;
            if (u < 1024) { const int qb = u & 15, hq = (u >> 4) & 15; b = u >> 8; qrow = CTXL + qb * 256; qcol = C_AQ + hq * HD; kcol = C_AK + (hq >> 2) * HD; vcol = C_AV + (hq >> 2) * HD; ocol = hq * HD; nt = TPB / 64; }
            else if (u < 1088) { const int v = u - 1024, hq = v & 15; b = v >> 4; qrow = 0; qcol = C_AQ + hq * HD; kcol = C_AK + (hq >> 2) * HD; vcol = C_AV + (hq >> 2) * HD; ocol = hq * HD; nt = CTXL / 64; }
            else { const int v = u - 1088, hb = v & 7; b = v >> 3; qrow = 0; qcol = C_BQ + hb * HD; kcol = C_BK + hb * HD; vcol = C_BV + hb * HD; ocol = 2048 + hb * HD; nt = CTXL / 64; }
            att::Tiles T; T.NT = nt; T.jmax = nt - 1; T.jsplit = 1 << 30; T.extra = 0; T.btab = nullptr; T.bmask = nullptr; T.bzero = nullptr; T.rlo = T.nrows = T.Rw = T.r0w = T.half = 0;
            const size_t rb = (size_t)b * TPB;
            f32x16 o[4];
            att::attn_core<0>(P, (unsigned)((rb + qrow) * INW + qcol), (unsigned)(rb * INW + kcol), (unsigned)(rb * INW + vcol), T, 0, lds, o);
            att::store_o_bf16(o, MIX + (rb + qrow) * D + ocol, lds);
        }
    }
    if (PHM & 0x2000) {
        for (int u = F.vcu; u < 512; u += F.G) {
            const int qb = u & 15, hb = (u >> 4) & 7, b = u >> 7;
            int rlo = 4 * qb - 4; rlo = rlo < 0 ? 0 : (rlo > 56 ? 56 : rlo);
            int rh = 4 * qb + 3 - 4; rh = rh < 0 ? 0 : (rh > 56 ? 56 : rh); const int nrows = rh + 8 - rlo;
            att::Tiles T; T.NT = (4 + nrows + 1) & ~1; T.jmax = 4 + nrows - 1; T.jsplit = 4; T.extra = rlo * 64;
            T.btab = (const float*)(F.ws + WS_BIAS) + (size_t)(l * 8 + hb) * 15 * 2 * 2048; T.bmask = (const float*)(F.ws + WS_BMASK); T.bzero = T.bmask + 2048;
            T.rlo = rlo; T.nrows = nrows; T.Rw = 4 * qb + (wave_ >> 1); { int r0 = T.Rw - 4; T.r0w = r0 < 0 ? 0 : (r0 > 56 ? 56 : r0); } T.half = wave_ & 1;
            const size_t rb = (size_t)b * TPB; const int qrow = CTXL + qb * 256;
            f32x16 o[4];
            att::attn_core<2>(P, (unsigned)((rb + qrow) * INW + C_BQ + hb * HD), (unsigned)(rb * INW + C_BK + hb * HD), (unsigned)(rb * INW + C_BV + hb * HD), T, 0, lds, o);
            att::store_o_bf16(o, MIX + (rb + qrow) * D + 2048 + hb * HD, lds);
        }
    }
    if (PHM & 0x4000) {
        const float lam = __hip_atomic_load((const float*)(F.ws + WS_LAM) + l, RLX_AGENT);
        const float lam_init = 0.8f - 0.6f * expf(-0.3f * (float)l);
        float* scr = (float*)(F.ws + WS_Y) + (size_t)blockIdx.x * 32768 + wave_ * 4096 + lane_ * 64;
        const float* gs = inp(I_SUBLN) + l * HD;
        const int nU = 512 + (last ? 0 : 32);
        for (int u = F.vcu; u < nU; u += F.G) {
            int b, hc, qrow, nt;
            if (u < 512) { const int qb = u & 15; hc = (u >> 4) & 7; b = u >> 7; qrow = CTXL + qb * 256; nt = TPB / 64; }
            else { const int v = u - 512; hc = v & 7; b = v >> 3; qrow = 0; nt = CTXL / 64; }
            att::Tiles T; T.NT = nt; T.jmax = nt - 1; T.jsplit = 1 << 30; T.extra = 0; T.btab = nullptr; T.bmask = nullptr; T.bzero = nullptr; T.rlo = T.nrows = T.Rw = T.r0w = T.half = 0;
            const size_t rb = (size_t)b * TPB;
#pragma unroll 1
            for (int comp = 0; comp < 2; ++comp) {
                f32x16 o[4];
                att::attn_core<1>(P, (unsigned)((rb + qrow) * INW + C_CQ + hc * HD + comp * 64), (unsigned)(rb * INW + C_CK + hc * HD), (unsigned)(rb * INW + C_CV + hc * HD), T, comp * 128, lds, o);
                if (comp == 0) {
#pragma unroll
                    for (int d0 = 0; d0 < 4; ++d0)
#pragma unroll
                        for (int q = 0; q < 4; ++q) *(f32x4*)(scr + d0 * 16 + q * 4) = (f32x4){o[d0][4 * q], o[d0][4 * q + 1], o[d0][4 * q + 2], o[d0][4 * q + 3]};
                } else {
                    const int r32 = lane_ & 31;
#pragma unroll
                    for (int d0 = 0; d0 < 4; ++d0)
#pragma unroll
                        for (int q = 0; q < 4; ++q) { const f32x4 t = *(const f32x4*)(scr + d0 * 16 + q * 4);
#pragma unroll
                            for (int j = 0; j < 4; ++j) o[d0][4 * q + j] = t[j] - lam * o[d0][4 * q + j]; }
                    float gv[4];
#pragma unroll
                    for (int d0 = 0; d0 < 4; ++d0) gv[d0] = gs[d0 * 32 + r32] * (1.0f - lam_init);
#pragma unroll
                    for (int r = 0; r < 16; ++r) { float ss = (o[0][r] * o[0][r] + o[1][r] * o[1][r]) + (o[2][r] * o[2][r] + o[3][r] * o[3][r]);
                        ss += __shfl_xor(ss, 1); ss += __shfl_xor(ss, 2); ss += __shfl_xor(ss, 4); ss += __shfl_xor(ss, 8); ss += __shfl_xor(ss, 16);
                        const float rs = 1.0f / sqrtf(ss * (1.0f / HD) + EPS);
#pragma unroll
                        for (int d0 = 0; d0 < 4; ++d0) o[d0][r] = o[d0][r] * rs * gv[d0]; }
                    att::store_o_bf16(o, MIX + (rb + qrow) * D + 3072 + hc * HD, lds);
                }
            }
        }
    }
}

constexpr int NPH_LAYER = 9;
constexpr int NPHASES = 3 + DEPTH * NPH_LAYER;

__global__ void __launch_bounds__(512, 2) trunk_fwd(Args args) {
    extern __shared__ __attribute__((aligned(16))) unsigned char lds_raw[];
    Frame F;
    F.lds = (LAS unsigned char*)lds_raw; F.ws = args.ws;
    F.G = gridDim.x; { const int bx = blockIdx.x; F.vcu = (F.G % 8 == 0) ? (bx % 8) * (F.G / 8) + bx / 8 : bx; }
    volatile LAS unsigned* MISC = (volatile LAS unsigned*)(F.lds + MISC_OFF);
    if (threadIdx.x < 64) MISC[threadIdx.x] = 0u;
    __syncthreads();
    unsigned* ctl = (unsigned*)(args.ws + WS_CTL);
    XcdBarrier bar; bar.bar = ctl + CW_BAR; bar.x = 0; bar.st = nullptr;
    const int lo = args.ph_lo, hi = args.ph_hi;
    if (hi - lo > 1) bar = xcd_barrier_post(ctl + CW_BAR + args.li * XCD_BAR_WORDS, MISC + 8);
#define IN(k) (lo <= (k) && (k) < hi)
#define SEAM(k) do { if (IN(k) && IN((k) + 1)) xcd_barrier(bar); } while (0)
    const float* MOD = (const float*)(args.ws + WS_MOD);

    if ((PHM & 1) && IN(0)) { phase_p0(F, args); } SEAM(0);
    if ((PHM & 2) && IN(1)) { phase_p1(F, args); } SEAM(1);
    if ((PHM & 4) && IN(2)) { phase_rows<0>(F, args, nullptr, nullptr, inp(I_NMPRE), MOD + 0 * D, MOD + 1 * D); } SEAM(2);

    for (int l = 0; l < DEPTH; ++l) {
        const int pb = 3 + l * NPH_LAYER;
        unsigned char* wb = args.ws + WS_W + (size_t)l * W_LAYER;
        const float* modl = MOD + (size_t)l * 5 * 6 * D;
        if ((PHM & 8) && IN(pb + 0)) {
            pg8::Gemm g{(const bf16*)(args.ws + WS_H), (const bf16*)(wb + W_IN), M, INW, D, D}; pg8::StaticOrder S; S.init(M, INW, F.G, (int)blockIdx.x);
            pg8::EpiBf16<0> E{(bf16*)(args.ws + WS_PROJ), INW, nullptr};
            pg8::gemm_phase<pg8::EpiBf16<0>, pg8::StaticOrder>(F.lds, g, S, E);
        } SEAM(pb + 0);
        if ((PHM & 16) && IN(pb + 1)) { phase_qk(F, args, l); } SEAM(pb + 1);
        if ((PHM & 32) && IN(pb + 2)) {
            phase_attn(F, args, l);
            __syncthreads();
            if (PHM & 0x8000) {
            pg8::Gemm g{(const bf16*)(args.ws + WS_PROJ) + C_GL, (const bf16*)(wb + W_GATE), M, 3 * D, GRK, INW}; pg8::StaticOrder S; S.init(M, 3 * D, F.G, (int)blockIdx.x);
            pg8::EpiBf16<2> E{(bf16*)(args.ws + WS_G), 3 * D, inp(I_BGATE) + (size_t)l * 3 * D};
            pg8::gemm_phase<pg8::EpiBf16<2>, pg8::StaticOrder>(F.lds, g, S, E); }
        } SEAM(pb + 2);
        if ((PHM & 64) && IN(pb + 3)) {
            pg8::Gemm g{(const bf16*)(args.ws + WS_MIX), (const bf16*)(wb + W_BR), M, D, D, D}; pg8::StaticOrder S; S.init(M, D, F.G, (int)blockIdx.x);
            pg8::EpiHorner E{(bf16*)(args.ws + WS_MRG), D, (const bf16*)(args.ws + WS_G)};
            pg8::gemm_phase<pg8::EpiHorner, pg8::StaticOrder>(F.lds, g, S, E);
        } SEAM(pb + 3);
        if ((PHM & 128) && IN(pb + 4)) {
            pg8::Gemm g{(const bf16*)(args.ws + WS_MRG), (const bf16*)(wb + W_OUT), M, D, D, D}; pg8::StaticOrder S; S.init(M, D, F.G, (int)blockIdx.x);
            pg8::EpiF32 E{(float*)(args.ws + WS_Y), D};
            pg8::gemm_phase<pg8::EpiF32, pg8::StaticOrder>(F.lds, g, S, E);
        } SEAM(pb + 4);
        if ((PHM & 256) && IN(pb + 5)) { phase_rows<1>(F, args, inp(I_NMPOST) + (size_t)l * D, modl + 2 * D, inp(I_NFPRE) + (size_t)l * D, modl + 3 * D, modl + 4 * D); } SEAM(pb + 5);
        if ((PHM & 512) && IN(pb + 6)) {
            pg8::Gemm g{(const bf16*)(args.ws + WS_H), (const bf16*)(wb + W_FFI), M, 2 * DFF, D, D}; pg8::StaticOrder S; S.init(M, 2 * DFF, F.G, (int)blockIdx.x);
            pg8::EpiSwiGLU E{(bf16*)(args.ws + WS_ACT), DFF};
            pg8::gemm_phase<pg8::EpiSwiGLU, pg8::StaticOrder>(F.lds, g, S, E);
        } SEAM(pb + 6);
        if ((PHM & 1024) && IN(pb + 7)) {
            pg8::Gemm g{(const bf16*)(args.ws + WS_ACT), (const bf16*)(wb + W_FFO), M, D, DFF, DFF}; pg8::StaticOrder S; S.init(M, D, F.G, (int)blockIdx.x);
            pg8::EpiF32 E{(float*)(args.ws + WS_Y), D};
            pg8::gemm_phase<pg8::EpiF32, pg8::StaticOrder>(F.lds, g, S, E);
        } SEAM(pb + 7);
        if ((PHM & 2048) && IN(pb + 8)) {
            if (l < DEPTH - 1) phase_rows<1>(F, args, inp(I_NFPOST) + (size_t)l * D, modl + 5 * D, inp(I_NMPRE) + (size_t)(l + 1) * D, modl + 5 * 6 * D + 0 * D, modl + 5 * 6 * D + 1 * D);
            else phase_rows<2>(F, args, inp(I_NFPOST) + (size_t)l * D, modl + 5 * D, nullptr, nullptr, nullptr);
        } SEAM(pb + 8);
    }
#undef IN
#undef SEAM
}

extern "C" void kernel_launch(void* const* d_in, const int* in_sizes, int n_in, void* d_out, int out_size, void* d_ws, size_t ws_size, hipStream_t stream) {
    static int grid = 0;
    if (grid == 0) {
        if (n_in != 26 || in_sizes[0] != NB * SEQ * D || out_size != NB * SEQ * D || ws_size < WS_END) { fprintf(stderr, "kernel_launch: shape mismatch (n_in %d, in0 %d, out %d, ws %zu < %zu)\n", n_in, n_in > 0 ? in_sizes[0] : -1, out_size, ws_size, (size_t)WS_END); grid = -1; return; }
        int dev = 0, cus = 0, per_cu = 0;
        if (hipGetDevice(&dev) != hipSuccess || hipDeviceGetAttribute(&cus, hipDeviceAttributeMultiprocessorCount, dev) != hipSuccess) { grid = -1; return; }
        if (hipFuncSetAttribute((const void*)trunk_fwd, hipFuncAttributeMaxDynamicSharedMemorySize, LDS_BYTES) != hipSuccess) { fprintf(stderr, "kernel_launch: hipFuncSetAttribute failed\n"); grid = -1; return; }
        if (hipOccupancyMaxActiveBlocksPerMultiprocessor(&per_cu, (const void*)trunk_fwd, 512, LDS_BYTES) != hipSuccess || per_cu < 1) fprintf(stderr, "kernel_launch: occupancy query says %d\n", per_cu);
        (void)hipGetLastError();
        grid = cus;
    }
    if (grid < 0) return;
    (void)hipMemsetAsync((char*)d_ws + WS_CTL, 0, CTL_ZERO_BYTES, stream);
    Args a{};
    for (int i = 0; i < 26; ++i) a.in[i] = (const float*)d_in[i];
    a.out = (float*)d_out; a.ws = (unsigned char*)d_ws; a.pad = 0;
#if MK_PER_PHASE
    for (int p = 0; p < NPHASES; ++p) { a.ph_lo = p; a.ph_hi = p + 1; a.li = 0; hipLaunchKernelGGL(trunk_fwd, dim3(grid), dim3(512), LDS_BYTES, stream, a); }
#else
    a.ph_lo = 0; a.ph_hi = NPHASES; a.li = 0; hipLaunchKernelGGL(trunk_fwd, dim3(grid), dim3(512), LDS_BYTES, stream, a);
#endif
    const hipError_t le = hipPeekAtLastError();
    if (le != hipSuccess) fprintf(stderr, "kernel_launch: launch failed: %s\n", hipGetErrorName(le));
}
```

```cpp
#include <hip/hip_runtime.h>
#include <cstdio>
#include <cstdint>

#ifndef PHM
#define PHM 0xffff
#endif
#ifndef PROBE_DUP
#define PROBE_DUP 0
#endif
#define DUPN(k) ((PROBE_DUP >> (k)) & 1 ? 2 : 1)
#ifndef MK_PER_PHASE
#define MK_PER_PHASE 0
#endif

__device__ __forceinline__ int opaque_tid() { int t = threadIdx.x; asm volatile("" : "+v"(t)); return t; }
namespace pg8 {
#define PG8_LAS __attribute__((address_space(3)))
typedef unsigned short bf16_t;
typedef short bf16x8 __attribute__((ext_vector_type(8)));
typedef float f32x4 __attribute__((ext_vector_type(4)));
typedef unsigned u32x4 __attribute__((ext_vector_type(4)));
constexpr int BM = 256, BK = 64, HALF = 128, HTB = HALF * BK * 2, STAGE_BYTES = 8 * HTB, NXCD = 8, WGM = 8;

__host__ __device__ __forceinline__ int lds_byte(int r, int c) { const int st = (r >> 4) * 2 + (c >> 5), rr = r & 15, cc = c & 31, ob = rr * 64 + cc * 2; return st * 1024 + (ob ^ (((ob >> 9) & 1) << 5)); }
__host__ __device__ __forceinline__ void stage_rc(int b, int& R, int& C) { const int st = b / 1024, sb = b % 1024, swz = sb ^ (((sb >> 9) & 1) << 5); R = (st >> 1) * 16 + swz / 64; C = (st & 1) * 32 + (swz % 64) / 2; }
__host__ __device__ __forceinline__ int perm32(int rho) { const int n = rho >> 4, i = rho & 15; return 8 * (i >> 2) + 4 * n + (i & 3); }

struct Unit { int pm, pn, kt0, nt, part; };
struct Gemm { const bf16_t* A; const bf16_t* Bt; int M, N, K, lda; };

struct Sched {
    int nMl, nN, nmain, G, c, NT, ntail, ksplit, tp0, pmode, xmode;
    __device__ __forceinline__ void init(int nMl_, int nN_, int NT_, int G_, int c_, int pmode_, int ntailp, int ksplit_, int tp0_, int xmode_) {
        nMl = nMl_; nN = nN_; nmain = nMl * nN; G = G_; c = c_; NT = NT_; ntail = ntailp * nN_; ksplit = ksplit_; tp0 = tp0_; pmode = pmode_; xmode = xmode_; }
    __device__ __forceinline__ bool next(int i, Unit& u) const {
        const int L = i * G + c;
        int pm = 0, pn = 0, kt0 = 0, nt = NT, part = -1; bool ok = true;
        const int s1 = L - nmain, s2 = s1 - ntail * ksplit;
        if (L < nmain) {
            int wgid = L; { const int q = nmain / NXCD, r = nmain % NXCD, xcd = wgid % NXCD, off = wgid / NXCD; wgid = (xcd < r ? xcd * (q + 1) : r * (q + 1) + (xcd - r) * q) + off; }
            const int nig = WGM * nN, gid = wgid / nig, fm = gid * WGM, gsz = (nMl - fm) < WGM ? (nMl - fm) : WGM;
            const int lp = fm + ((wgid % nig) % gsz); pn = (wgid % nig) / gsz; pm = pmode ? (lp >> 4) * 17 + 1 + (lp & 15) : lp;
        } else if (s2 < 0) {
            const int tile = s1 / ksplit, p = s1 % ksplit, q = NT / ksplit, p1 = p + 1; pm = tp0 + tile / nN; pn = tile % nN; part = p;
            const int st = p * q + ((q & 1) ? (p <= ksplit / 2 ? p : ksplit - p) : 0), en = p1 * q + ((q & 1) ? (p1 <= ksplit / 2 ? p1 : ksplit - p1) : 0); kt0 = st; nt = en - st;
        } else if (xmode && s2 < 80) {
            const int j = s2 % 20; pm = 17 * (s2 / 20); pn = (j < 4) ? 8 + j : (j < 12 ? 16 + (j - 4) : 28 + (j - 12));
        } else ok = false;
        u.pm = pm; u.pn = pn; u.kt0 = kt0; u.nt = nt; u.part = part;
        return ok;
    }
    __device__ __forceinline__ void a_ready(const Unit&) const {}
    __device__ __forceinline__ void done(const Unit&) const {}
};

__device__ __forceinline__ unsigned cvt_pk_bf16(float lo, float hi) { unsigned r; asm volatile("v_cvt_pk_bf16_f32 %0, %1, %2" : "=v"(r) : "v"(lo), "v"(hi)); return r; }
__device__ __forceinline__ float sigm(float x) { return __builtin_amdgcn_rcpf(1.0f + __builtin_amdgcn_exp2f(-1.4426950408889634f * x)); }
__device__ __forceinline__ f32x4 bf4lo(unsigned a, unsigned b) { return (f32x4){__uint_as_float(a << 16), __uint_as_float(a & 0xffff0000u), __uint_as_float(b << 16), __uint_as_float(b & 0xffff0000u)}; }

template <int ACT> struct EpiBf16 {
    static constexpr bool PERM = true, AFTER_DRAIN = false, HORNER = false;
    bf16_t* O; int ldc; const float* bias;
    __device__ __forceinline__ void mid(f32x4 (&)[2][2][4][2], const Unit&, int, int, int, int, int) const {}
    __device__ __forceinline__ void operator()(const f32x4 (&acc)[2][2][4][2], const Unit& u, int wr, int wc, int fr, int fq) const {
        const int row0 = u.pm * BM + wr * 64 + fr; const int col0 = u.pn * BM + wc * 32 + 8 * fq;
        f32x4 bv[2][2];
#pragma unroll
        for (int bj = 0; bj < 2; ++bj)
#pragma unroll
            for (int n = 0; n < 2; ++n) bv[bj][n] = (ACT == 2) ? *(const f32x4*)(bias + col0 + bj * HALF + 4 * n) : (f32x4){0.f, 0.f, 0.f, 0.f};
#pragma unroll
        for (int ai = 0; ai < 2; ++ai)
#pragma unroll
            for (int m = 0; m < 4; ++m) { bf16_t* rowp = O + (size_t)(row0 + ai * HALF + m * 16) * ldc + col0;
#pragma unroll
                for (int bj = 0; bj < 2; ++bj) { f32x4 v0 = acc[ai][bj][m][0] + bv[bj][0], v1 = acc[ai][bj][m][1] + bv[bj][1];
                    if (ACT == 2) {
#pragma unroll
                        for (int j = 0; j < 4; ++j) { v0[j] = fmaxf(sigm(v0[j]), 1e-12f); v1[j] = fmaxf(sigm(v1[j]), 1e-12f); } }
                    u32x4 w; w.x = cvt_pk_bf16(v0[0], v0[1]); w.y = cvt_pk_bf16(v0[2], v0[3]); w.z = cvt_pk_bf16(v1[0], v1[1]); w.w = cvt_pk_bf16(v1[2], v1[3]);
                    *(u32x4*)(rowp + bj * HALF) = w; } }
    }
};
struct EpiSwiGLU {
    static constexpr bool PERM = true, AFTER_DRAIN = false, HORNER = false;
    bf16_t* O; int ldc;
    __device__ __forceinline__ void mid(f32x4 (&)[2][2][4][2], const Unit&, int, int, int, int, int) const {}
    __device__ __forceinline__ void operator()(const f32x4 (&acc)[2][2][4][2], const Unit& u, int wr, int wc, int fr, int fq) const {
        const int row0 = u.pm * BM + wr * 64 + fr; const int col0 = u.pn * HALF + wc * 32 + 8 * fq;
#pragma unroll
        for (int ai = 0; ai < 2; ++ai)
#pragma unroll
            for (int m = 0; m < 4; ++m) { bf16_t* rowp = O + (size_t)(row0 + ai * HALF + m * 16) * ldc + col0;
                f32x4 g0 = acc[ai][0][m][0], g1 = acc[ai][0][m][1]; const f32x4 u0 = acc[ai][1][m][0], u1 = acc[ai][1][m][1];
#pragma unroll
                for (int j = 0; j < 4; ++j) { g0[j] = g0[j] * sigm(g0[j]) * u0[j]; g1[j] = g1[j] * sigm(g1[j]) * u1[j]; }
                u32x4 w; w.x = cvt_pk_bf16(g0[0], g0[1]); w.y = cvt_pk_bf16(g0[2], g0[3]); w.z = cvt_pk_bf16(g1[0], g1[1]); w.w = cvt_pk_bf16(g1[2], g1[3]);
                *(u32x4*)rowp = w; }
    }
};
struct EpiF32 {
    static constexpr bool PERM = false, AFTER_DRAIN = false, HORNER = false;
    float* C; int ldc; float* Cp; int tp0; size_t pstride;
    __device__ __forceinline__ void mid(f32x4 (&)[2][2][4][2], const Unit&, int, int, int, int, int) const {}
    __device__ __forceinline__ void operator()(const f32x4 (&acc)[2][2][4][2], const Unit& u, int wr, int wc, int fr, int fq) const {
        const int col0 = u.pn * BM + wc * 32 + 4 * fq; const int rowl = wr * 64 + fr;
        float* base = (u.part < 0) ? C + (size_t)(u.pm * BM + rowl) * ldc : Cp + (size_t)u.part * pstride + (size_t)((u.pm - tp0) * BM + rowl) * ldc;
#pragma unroll
        for (int ai = 0; ai < 2; ++ai)
#pragma unroll
            for (int m = 0; m < 4; ++m) { float* rowp = base + (size_t)(ai * HALF + m * 16) * ldc + col0;
#pragma unroll
                for (int bj = 0; bj < 2; ++bj)
#pragma unroll
                    for (int n = 0; n < 2; ++n) *(f32x4*)(rowp + bj * HALF + n * 16) = acc[ai][bj][m][n]; }
    }
};
struct EpiHorner {
    static constexpr bool PERM = true, AFTER_DRAIN = false, HORNER = true;
    bf16_t* O; int ldc; const bf16_t* G;
    __device__ __forceinline__ void mid(f32x4 (&acc)[2][2][4][2], const Unit& u, int t, int wr, int wc, int fr, int fq) const {
        const __amdgpu_buffer_rsrc_t rs = __builtin_amdgcn_make_buffer_rsrc((void*)G, 0, (int)(17408u * 12288u * 2u), 0x00020000);
        const unsigned vo = (unsigned)((wr * 64 + fr) * 12288 + wc * 32 + 8 * fq) * 2u;
        const unsigned so0 = (unsigned)__builtin_amdgcn_readfirstlane((u.pm * BM * 12288 + u.pn * BM + ((t == 32) ? 0 : 4096)) * 2);
#pragma unroll
        for (int ai = 0; ai < 2; ++ai)
#pragma unroll
            for (int m = 0; m < 4; ++m)
#pragma unroll
                for (int bj = 0; bj < 2; ++bj) { const unsigned so = so0 + (unsigned)(((ai * HALF + m * 16) * 12288 + bj * HALF) * 2);
                    const u32x4 a = __builtin_amdgcn_raw_buffer_load_b128(rs, vo, so, 0), b = __builtin_amdgcn_raw_buffer_load_b128(rs, vo, so + 8192u, 0);
                    const f32x4 a0 = bf4lo(a.x, a.y), a1 = bf4lo(a.z, a.w), b0 = bf4lo(b.x, b.y), b1 = bf4lo(b.z, b.w);
#pragma unroll
                    for (int j = 0; j < 4; ++j) { acc[ai][bj][m][0][j] *= a0[j] * __builtin_amdgcn_rcpf(b0[j]); acc[ai][bj][m][1][j] *= a1[j] * __builtin_amdgcn_rcpf(b1[j]); }
                    if (bj) asm volatile("" ::: "memory"); }
    }
    __device__ __forceinline__ void operator()(const f32x4 (&acc)[2][2][4][2], const Unit& u, int wr, int wc, int fr, int fq) const {
        const __amdgpu_buffer_rsrc_t rs = __builtin_amdgcn_make_buffer_rsrc((void*)G, 0, (int)(17408u * 12288u * 2u), 0x00020000);
        const unsigned vo = (unsigned)((wr * 64 + fr) * 12288 + wc * 32 + 8 * fq) * 2u;
        const unsigned so0 = (unsigned)__builtin_amdgcn_readfirstlane((u.pm * BM * 12288 + u.pn * BM + 8192) * 2);
        const int row0 = u.pm * BM + wr * 64 + fr; const int col0 = u.pn * BM + wc * 32 + 8 * fq;
#pragma unroll
        for (int ai = 0; ai < 2; ++ai)
#pragma unroll
            for (int m = 0; m < 4; ++m) { bf16_t* rowp = O + (size_t)(row0 + ai * HALF + m * 16) * ldc + col0;
#pragma unroll
                for (int bj = 0; bj < 2; ++bj) { const unsigned so = so0 + (unsigned)(((ai * HALF + m * 16) * 12288 + bj * HALF) * 2);
                    const u32x4 c = __builtin_amdgcn_raw_buffer_load_b128(rs, vo, so, 0); const f32x4 v0 = acc[ai][bj][m][0] * bf4lo(c.x, c.y), v1 = acc[ai][bj][m][1] * bf4lo(c.z, c.w);
                    u32x4 w; w.x = cvt_pk_bf16(v0[0], v0[1]); w.y = cvt_pk_bf16(v0[2], v0[3]); w.z = cvt_pk_bf16(v1[0], v1[1]); w.w = cvt_pk_bf16(v1[2], v1[3]);
                    *(u32x4*)(rowp + bj * HALF) = w; }
                asm volatile("" ::: "memory"); }
    }
};

template <class Epi, class Sched_, bool ALIGN_EPI = true, bool SP2 = true>
__device__ __forceinline__ void gemm_phase(PG8_LAS unsigned char* lds, const Gemm g, const Sched_& S, const Epi& E) {
    const int tid = opaque_tid(), wid = __builtin_amdgcn_readfirstlane(tid >> 6), lane = tid & 63, wr = wid >> 2, wc = wid & 3, fr = lane & 15, fq = lane >> 4;
    const int K = g.K;
    unsigned voffA[2], voffB[2];
#pragma unroll
    for (int i = 0; i < 2; ++i) { int R, C; stage_rc(tid * 16 + i * 8192, R, C); const int Rb = Epi::PERM ? ((R & ~31) + perm32(R & 31)) : R;
        voffA[i] = (unsigned)(R * g.lda + C) * 2u; voffB[i] = (unsigned)(Rb * K + C) * 2u; }
    const size_t kstep = (size_t)(BK * 2);
    const size_t hstepB = (size_t)HALF * K * 2, hstepA = (size_t)HALF * g.lda * 2;
    const size_t tstepB = 2 * hstepB, tstepA = 2 * hstepA;
    const unsigned ldsw = (unsigned)wid * 1024u;
    const int aoff = lds_byte(wr * 64 + fr, fq * 8), boff = lds_byte(wc * 32 + fr, fq * 8);
#define PG8_SA(b, h) (((b) * 2 + (h)) * HTB)
#define PG8_SB(b, h) ((4 + (b) * 2 + (h)) * HTB)
#define PG8_STAGE(bufoff, gbase, voff) do { _Pragma("unroll") for (int _i = 0; _i < 2; ++_i) \
        __builtin_amdgcn_global_load_lds((const unsigned*)((const char*)(gbase) + (voff)[_i]), (PG8_LAS unsigned*)(lds + (bufoff) + ldsw + _i * 8192), 16, 0, 0); } while (0)
#define PG8_LDA(dst, b, h) do { _Pragma("unroll") for (int m = 0; m < 4; ++m) _Pragma("unroll") for (int k = 0; k < 2; ++k) dst[m][k] = *(const PG8_LAS bf16x8*)(lds + PG8_SA(b, h) + aoff + m * 2048 + k * 1024); } while (0)
#define PG8_LDB(dst, b, h) do { _Pragma("unroll") for (int n = 0; n < 2; ++n) _Pragma("unroll") for (int k = 0; k < 2; ++k) dst[n][k] = *(const PG8_LAS bf16x8*)(lds + PG8_SB(b, h) + boff + n * 2048 + k * 1024); } while (0)
#define PG8_MMA(ai, bj, At, Bt) do { __builtin_amdgcn_s_setprio(1); _Pragma("unroll") for (int m = 0; m < 4; ++m) _Pragma("unroll") for (int n = 0; n < 2; ++n) _Pragma("unroll") for (int k = 0; k < 2; ++k) \
        acc[ai][bj][m][n] = __builtin_amdgcn_mfma_f32_16x16x32_bf16(Bt[n][k], At[m][k], acc[ai][bj][m][n], 0, 0, 0); __builtin_amdgcn_s_setprio(0); } while (0)
#define PG8_WAIT_V(n) asm volatile("s_waitcnt vmcnt(" #n ")" ::: "memory")
#define PG8_WAIT_L(n) asm volatile("s_waitcnt lgkmcnt(" #n ")" ::: "memory")
#define PG8_BAR __builtin_amdgcn_s_barrier()
#define PG8_SCHED __builtin_amdgcn_sched_barrier(0)
    Unit cur, nxt; int ui = 0;
    if (!S.next(0, cur)) return;
    f32x4 acc[2][2][4][2];
#pragma unroll
    for (int a = 0; a < 2; ++a)
#pragma unroll
        for (int b = 0; b < 2; ++b)
#pragma unroll
            for (int m = 0; m < 4; ++m)
#pragma unroll
                for (int n = 0; n < 2; ++n) acc[a][b][m][n] = (f32x4){0.f, 0.f, 0.f, 0.f};
    bf16x8 At[4][2], B0[2][2], B1[2][2];
    const char* cA = (const char*)g.A + (size_t)cur.pm * tstepA + (size_t)cur.kt0 * kstep; const char* cB = (const char*)g.Bt + (size_t)cur.pn * tstepB + (size_t)cur.kt0 * kstep;
    S.a_ready(cur);
    if constexpr (SP2) {
        PG8_STAGE(PG8_SB(0, 0), cB, voffB); PG8_STAGE(PG8_SB(0, 1), cB + hstepB, voffB); PG8_STAGE(PG8_SA(0, 0), cA, voffA); PG8_STAGE(PG8_SA(0, 1), cA + hstepA, voffA);
        if (wr == 1) PG8_BAR;
        PG8_WAIT_V(2); PG8_BAR;
        PG8_STAGE(PG8_SB(1, 0), cB + kstep, voffB); PG8_STAGE(PG8_SA(1, 0), cA + kstep, voffA); PG8_STAGE(PG8_SB(1, 1), cB + hstepB + kstep, voffB);
        PG8_WAIT_V(6); PG8_BAR;
    } else {
        PG8_STAGE(PG8_SB(0, 0), cB, voffB); PG8_STAGE(PG8_SA(0, 0), cA, voffA); PG8_STAGE(PG8_SB(0, 1), cB + hstepB, voffB); PG8_STAGE(PG8_SA(0, 1), cA + hstepA, voffA);
        if (wr == 1) PG8_BAR;
        PG8_WAIT_V(4); PG8_BAR;
        PG8_STAGE(PG8_SB(1, 0), cB + kstep, voffB); PG8_STAGE(PG8_SA(1, 0), cA + kstep, voffA); PG8_STAGE(PG8_SB(1, 1), cB + hstepB + kstep, voffB);
        PG8_WAIT_V(6); PG8_BAR;
    }
    for (;;) {
        const bool has_next = S.next(ui + 1, nxt);
        const char* nA = has_next ? (const char*)g.A + (size_t)nxt.pm * tstepA + (size_t)nxt.kt0 * kstep : cA; const char* nB = has_next ? (const char*)g.Bt + (size_t)nxt.pn * tstepB + (size_t)nxt.kt0 * kstep : cB;
        const int nt = cur.nt;
        for (int t = 0; t < nt; t += 2) {
            const bool last = (t == nt - 2);
            const char* a1 = cA + (size_t)(t + 1) * kstep;
            const char* a2 = last ? nA : cA + (size_t)(t + 2) * kstep; const char* b2 = last ? nB : cB + (size_t)(t + 2) * kstep;
            const char* a3 = a2 + kstep; const char* b3 = b2 + kstep;
            if constexpr (Epi::HORNER) { if (t + cur.kt0 == 32 || t + cur.kt0 == 48) E.mid(acc, cur, t + cur.kt0, wr, wc, fr, fq); }
            if (last && has_next) S.a_ready(nxt);
            if constexpr (SP2) {
            PG8_LDB(B0, 0, 0); PG8_LDB(B1, 0, 1); PG8_SCHED; PG8_LDA(At, 0, 0); PG8_STAGE(PG8_SA(1, 1), a1 + hstepA, voffA);
            PG8_WAIT_V(8); PG8_WAIT_L(0); PG8_BAR; PG8_MMA(0, 0, At, B0); PG8_MMA(0, 1, At, B1); PG8_BAR; PG8_SCHED;
            PG8_LDA(At, 0, 1); PG8_STAGE(PG8_SB(0, 0), b2, voffB); PG8_STAGE(PG8_SB(0, 1), b2 + hstepB, voffB); PG8_STAGE(PG8_SA(0, 0), a2, voffA);
            PG8_WAIT_V(8); PG8_WAIT_L(0); PG8_BAR; PG8_MMA(1, 0, At, B0); PG8_MMA(1, 1, At, B1); PG8_BAR; PG8_SCHED;
            PG8_LDB(B0, 1, 0); PG8_LDB(B1, 1, 1); PG8_SCHED; PG8_LDA(At, 1, 0); PG8_STAGE(PG8_SA(0, 1), a2 + hstepA, voffA);
            PG8_WAIT_V(8); PG8_WAIT_L(0); PG8_BAR; PG8_MMA(0, 0, At, B0); PG8_MMA(0, 1, At, B1); PG8_BAR; PG8_SCHED;
            PG8_LDA(At, 1, 1); PG8_STAGE(PG8_SB(1, 0), b3, voffB); PG8_STAGE(PG8_SB(1, 1), b3 + hstepB, voffB); PG8_STAGE(PG8_SA(1, 0), a3, voffA);
            PG8_WAIT_V(8); PG8_WAIT_L(0); PG8_BAR; PG8_MMA(1, 0, At, B0); PG8_MMA(1, 1, At, B1); PG8_BAR; PG8_SCHED;
            } else {
            PG8_LDB(B0, 0, 0); PG8_SCHED; PG8_LDA(At, 0, 0); PG8_STAGE(PG8_SA(1, 1), a1 + hstepA, voffA);
            PG8_WAIT_L(8); PG8_BAR; PG8_WAIT_L(0); PG8_MMA(0, 0, At, B0); PG8_BAR; PG8_SCHED;
            PG8_LDB(B1, 0, 1); PG8_STAGE(PG8_SB(0, 0), b2, voffB);
            PG8_BAR; PG8_WAIT_L(0); PG8_MMA(0, 1, At, B1); PG8_BAR;
            PG8_LDA(At, 0, 1); PG8_STAGE(PG8_SA(0, 0), a2, voffA);
            PG8_BAR; PG8_WAIT_L(0); PG8_MMA(1, 0, At, B0); PG8_BAR; PG8_SCHED;
            PG8_STAGE(PG8_SB(0, 1), b2 + hstepB, voffB);
            PG8_WAIT_V(6); PG8_BAR; PG8_MMA(1, 1, At, B1); PG8_BAR;
            PG8_LDB(B0, 1, 0); PG8_SCHED; PG8_LDA(At, 1, 0); PG8_STAGE(PG8_SA(0, 1), a2 + hstepA, voffA);
            PG8_WAIT_L(8); PG8_BAR; PG8_WAIT_L(0); PG8_MMA(0, 0, At, B0); PG8_BAR; PG8_SCHED;
            PG8_LDB(B1, 1, 1); PG8_STAGE(PG8_SB(1, 0), b3, voffB);
            PG8_BAR; PG8_WAIT_L(0); PG8_MMA(0, 1, At, B1); PG8_BAR;
            PG8_LDA(At, 1, 1); PG8_STAGE(PG8_SA(1, 0), a3, voffA);
            PG8_BAR; PG8_WAIT_L(0); PG8_MMA(1, 0, At, B0); PG8_BAR; PG8_SCHED;
            PG8_STAGE(PG8_SB(1, 1), b3 + hstepB, voffB);
            PG8_WAIT_V(6); PG8_BAR; PG8_MMA(1, 1, At, B1); PG8_BAR;
            }
        }
        if constexpr (ALIGN_EPI) { if (wr == 0) PG8_BAR; }
        E(acc, cur, wr, wc, fr, fq); S.done(cur);
        if (!has_next) break;
#pragma unroll
        for (int a = 0; a < 2; ++a)
#pragma unroll
            for (int b = 0; b < 2; ++b)
#pragma unroll
                for (int m = 0; m < 4; ++m)
#pragma unroll
                    for (int n = 0; n < 2; ++n) acc[a][b][m][n] = (f32x4){0.f, 0.f, 0.f, 0.f};
        cur = nxt; cA = nA; cB = nB; ++ui;
        if constexpr (ALIGN_EPI) { if (wr == 1) PG8_BAR; }
    }
    PG8_WAIT_V(0);
    if constexpr (!ALIGN_EPI) { if (wr == 0) PG8_BAR; }
    PG8_BAR;
#undef PG8_SA
#undef PG8_SB
#undef PG8_STAGE
#undef PG8_LDA
#undef PG8_LDB
#undef PG8_MMA
#undef PG8_WAIT_V
#undef PG8_WAIT_L
#undef PG8_BAR
#undef PG8_SCHED
}
}

constexpr int D = 4096, NB = 4, SEQ = 4096, DEPTH = 4, GRIDW = 64, CTXL = 256, HD = 128;
constexpr int TPB = CTXL + SEQ;
constexpr int M = NB * TPB;
constexpr int INW = 9728, DFF = 11008, GRK = 512, ADAR = 256;
constexpr int C_AQ = 0, C_AK = 2048, C_AV = 2560, C_BQ = 3072, C_BK = 4096, C_BV = 5120, C_CQ = 6144, C_CK = 7168, C_CV = 8192, C_GL = 9216;
constexpr float EPS = 1e-6f;

constexpr size_t MiB = 1u << 20;
constexpr size_t WS_CTL = 0, CTL_ZERO_BYTES = 1 * MiB;
constexpr size_t WS_T1P = 1 * MiB;
constexpr size_t WS_MOD = 2 * MiB;
constexpr size_t WS_ROPE = 4 * MiB;
constexpr size_t WS_LAM = 4 * MiB + 65536;
constexpr size_t WS_BMASK = 5 * MiB;
constexpr size_t WS_BIAS = 6 * MiB;
constexpr size_t WS_W = 16 * MiB;
constexpr size_t W_IN = 0, W_GATE = W_IN + (size_t)INW * D * 2, W_BR = W_GATE + (size_t)3 * D * GRK * 2, W_OUT = W_BR + (size_t)D * D * 2,
                 W_FFI = W_OUT + (size_t)D * D * 2, W_FFO = W_FFI + (size_t)2 * DFF * D * 2, W_LAYER = W_FFO + (size_t)D * DFF * 2;
constexpr size_t WS_X = 1664 * MiB;
constexpr size_t WS_H = 1936 * MiB;
constexpr size_t WS_PROJ = 2072 * MiB;
constexpr size_t WS_MIX = 2395 * MiB;
constexpr size_t WS_G = 2531 * MiB;
constexpr size_t WS_MRG = 2939 * MiB;
constexpr size_t WS_Y = 3075 * MiB;
constexpr size_t WS_ACT = 3347 * MiB;
constexpr size_t WS_YP = 3713 * MiB;
constexpr size_t WS_END = 3777 * MiB;
static_assert(WS_W + DEPTH * W_LAYER <= WS_X && WS_X + (size_t)M * D * 4 <= WS_H && WS_H + (size_t)M * D * 2 <= WS_PROJ && WS_PROJ + (size_t)M * INW * 2 <= WS_MIX &&
              WS_MIX + (size_t)M * D * 2 <= WS_G && WS_G + (size_t)M * 3 * D * 2 <= WS_MRG && WS_MRG + (size_t)M * D * 2 <= WS_Y && WS_Y + (size_t)M * D * 4 <= WS_ACT &&
              WS_ACT + (size_t)M * DFF * 2 <= WS_YP && WS_YP + (size_t)4 * 1024 * D * 4 <= WS_END && WS_BIAS + (size_t)4 * 8 * 15 * 2 * 2048 * 4 <= WS_W, "d_ws map");
constexpr int CW_BAR = 4096;

constexpr int RING_BYTES = 139264;
constexpr int MISC_OFF = RING_BYTES;
constexpr int LDS_BYTES = 147456;
static_assert(MISC_OFF + 256 <= LDS_BYTES, "LDS map");

#define GAS __attribute__((address_space(1)))
#define LAS __attribute__((address_space(3)))
typedef unsigned short bf16;
typedef unsigned v4u __attribute__((ext_vector_type(4)));
typedef unsigned v2u __attribute__((ext_vector_type(2)));
typedef float f32x4 __attribute__((ext_vector_type(4)));
typedef short bf16x8 __attribute__((ext_vector_type(8)));
typedef short s16x4 __attribute__((ext_vector_type(4)));
typedef float f32x16 __attribute__((ext_vector_type(16)));
#define RLX_AGENT __ATOMIC_RELAXED, __HIP_MEMORY_SCOPE_AGENT
__device__ __forceinline__ unsigned f2bf(float f) { unsigned u = __builtin_bit_cast(unsigned, f); return (u + 0x7fffu + ((u >> 16) & 1u)) >> 16; }
__device__ __forceinline__ unsigned pk2(float lo, float hi) { return pg8::cvt_pk_bf16(lo, hi); }
__device__ __forceinline__ float bflo(unsigned w) { return __uint_as_float(w << 16); }
__device__ __forceinline__ float bfhi(unsigned w) { return __uint_as_float(w & 0xffff0000u); }
__device__ __forceinline__ float wave_sum(float v) {
#pragma unroll
    for (int o = 1; o < 64; o <<= 1) v += __shfl_xor(v, o);
    return v;
}

#define XB_TMO      128
#define XB_XCNT(j)  (256  + 64 * (j))
#define XB_XSUB(j)  (1280 + 64 * (j))
#define XB_XGEN(j)  (2304 + 64 * (j))
#define XB_TOP      3328
#define XB_TOPGEN   3392
#define XCD_BAR_WORDS 3456
#define XB_SPIN_CAP (1u << 22)
__device__ __forceinline__ unsigned xb_ld(unsigned* p)              { return __hip_atomic_load(p, __ATOMIC_RELAXED, __HIP_MEMORY_SCOPE_AGENT); }
__device__ __forceinline__ unsigned xb_add(unsigned* p, unsigned v) { return __hip_atomic_fetch_add(p, v, __ATOMIC_RELAXED, __HIP_MEMORY_SCOPE_AGENT); }
__device__ __forceinline__ unsigned xb_xcc_id() { return (unsigned)__builtin_amdgcn_s_getreg((3 << 11) | 20) & 0xFu; }
#define XB_SPIN(cond, bar) do { unsigned _sp = 0; while (cond) { __builtin_amdgcn_s_sleep(1); \
    if ((++_sp & 255u) == 0u) { if (xb_ld(&(bar)[XB_TMO])) break; if (_sp > XB_SPIN_CAP) { atomicAdd(&(bar)[XB_TMO], 1u); break; } } } } while (0)
struct XcdBarrier { unsigned* bar; unsigned x; volatile LAS unsigned* st; };
__device__ __forceinline__ XcdBarrier xcd_barrier_post(unsigned* bar, volatile LAS unsigned* st) {
    XcdBarrier b; b.bar = bar; b.x = xb_xcc_id(); b.st = st;
    if (threadIdx.x == 0) (void)xb_add(&bar[XB_XCNT(b.x)], 1u);
    return b;
}
__device__ __forceinline__ void xcd_barrier_complete(unsigned* bar, unsigned x, unsigned& nloc, unsigned& nx) {
    const unsigned G = gridDim.x * gridDim.y * gridDim.z;
    unsigned sum, cnt, mine, sp = 0u;
    for (;;) {
        sum = 0u; cnt = 0u; mine = 0u;
#pragma unroll
        for (unsigned j = 0; j < 16; ++j) { const unsigned c = xb_ld(&bar[XB_XCNT(j)]); sum += c; cnt += (c > 0u) ? 1u : 0u; mine = (j == x) ? c : mine; }
        if (sum == G) break;
        __builtin_amdgcn_s_sleep(1);
        if ((++sp & 255u) == 0u) { if (xb_ld(&bar[XB_TMO])) break; if (sp > XB_SPIN_CAP) { atomicAdd(&bar[XB_TMO], 1u); break; } }
    }
    nloc = mine > 0u ? mine : 1u; nx = cnt > 0u ? cnt : 1u;
}
__device__ __forceinline__ void xcd_barrier(const XcdBarrier& b) {
    asm volatile("s_waitcnt vmcnt(0)" ::: "memory");
    __syncthreads();
    if (threadIdx.x == 0) {
        unsigned* bar = b.bar;
        __builtin_amdgcn_s_waitcnt(0);
        unsigned nloc = b.st[0], nx = b.st[1];
        if (nloc == 0u) { xcd_barrier_complete(bar, b.x, nloc, nx); b.st[0] = nloc; b.st[1] = nx; }
        const unsigned old = xb_add(&bar[XB_XSUB(b.x)], 1u);
        const unsigned gen = old / nloc;
        if (old + 1u == (gen + 1u) * nloc) {
            __builtin_amdgcn_fence(__ATOMIC_RELEASE, "agent");
            asm volatile("s_waitcnt vmcnt(0)" ::: "memory");
            const unsigned og = xb_add(&bar[XB_TOP], 1u);
            const unsigned tg = og / nx;
            if (og + 1u == (tg + 1u) * nx) xb_add(&bar[XB_TOPGEN], 1u);
            else XB_SPIN(xb_ld(&bar[XB_TOPGEN]) == tg, bar);
            __builtin_amdgcn_fence(__ATOMIC_ACQUIRE, "agent");
            xb_add(&bar[XB_XGEN(b.x)], 1u);
            asm volatile("s_waitcnt vmcnt(0)" ::: "memory");
        } else {
            XB_SPIN(xb_ld(&bar[XB_XGEN(b.x)]) == gen, bar);
            __builtin_amdgcn_fence(__ATOMIC_ACQUIRE, "agent");
            asm volatile("s_waitcnt vmcnt(0)" ::: "memory");
        }
    }
    __syncthreads();
}

namespace att {
constexpr int KVBLK = 64, LDQ = INW, LDK = INW;
constexpr int SHM_V = KVBLK * 128 * 2, SHM_K = KVBLK * 128 * 2, WS_OFF = 2 * SHM_V + 2 * SHM_K, OST_OFF = WS_OFF + 8 * 64 * 4, OST_STRIDE = 272, OST_WAVE = 32 * OST_STRIDE, LDS_NEED = OST_OFF + 8 * OST_WAVE;
static_assert(LDS_NEED <= RING_BYTES, "attention LDS");
#define KSWZ(row, colB) ((row) * 256 + ((colB) ^ (((row) & 7) << 4)))
#define SBAR() __builtin_amdgcn_sched_barrier(0)
__device__ __forceinline__ int crow(int r, int hi) { return (r & 3) + 8 * (r >> 2) + 4 * hi; }
__device__ __forceinline__ unsigned cvtpk(float lo, float hi) { unsigned r; asm volatile("v_cvt_pk_bf16_f32 %0, %1, %2" : "=v"(r) : "v"(lo), "v"(hi)); return r; }
constexpr float THR = 8.f;
template <int MODE> struct Cfg { static constexpr float SCALE = (MODE == 1) ? 0.125f : 0.088388347648318440f; static constexpr int ND0 = (MODE == 1) ? 4 : 8; };

template <int MODE> __device__ __forceinline__ void partialSM(f32x16& p0, f32x16& p1, float& m_reg, float& mn, float& alpha) {
  constexpr float SC = Cfg<MODE>::SCALE, C = SC * 1.4426950408889634f;
  float pmax = p0[0]; for (int r = 1; r < 16; ++r) pmax = fmaxf(pmax, p0[r]); for (int r = 0; r < 16; ++r) pmax = fmaxf(pmax, p1[r]);
  { auto rr = __builtin_amdgcn_permlane32_swap(__float_as_uint(pmax), __float_as_uint(pmax), false, false);
    pmax = fmaxf(__uint_as_float(rr[0]), __uint_as_float(rr[1])); }
  if (__builtin_expect(__all(pmax - m_reg <= THR / SC), 1)) { mn = m_reg; alpha = 1.f; }
  else { mn = fmaxf(m_reg, pmax); alpha = __builtin_amdgcn_exp2f((m_reg - mn) * C); m_reg = mn; }
  float mnC = -mn * C;
  for (int r = 0; r < 16; ++r) p0[r] = fmaf(p0[r], C, mnC); for (int r = 0; r < 16; ++r) p1[r] = fmaf(p1[r], C, mnC);
  for (int r = 0; r < 16; ++r) p0[r] = __builtin_amdgcn_exp2f(p0[r]);
}
__device__ __forceinline__ void finishSM(f32x16& p0, f32x16& p1, float alpha, float& l_reg, bf16x8& pa0, bf16x8& pa1, bf16x8& pa2, bf16x8& pa3) {
  for (int r = 0; r < 16; ++r) p1[r] = __builtin_amdgcn_exp2f(p1[r]);
  float ps = 0; for (int r = 0; r < 16; ++r) ps += p0[r]; for (int r = 0; r < 16; ++r) ps += p1[r];
  { auto rr = __builtin_amdgcn_permlane32_swap(__float_as_uint(ps), __float_as_uint(ps), false, false);
    ps = __uint_as_float(rr[0]) + __uint_as_float(rr[1]); }
  l_reg = l_reg * alpha + ps;
#define PK4(P, BASE, OUT) do { unsigned a0 = cvtpk(P[BASE + 0], P[BASE + 1]), a1 = cvtpk(P[BASE + 2], P[BASE + 3]);   \
    unsigned b0 = cvtpk(P[BASE + 4], P[BASE + 5]), b1 = cvtpk(P[BASE + 6], P[BASE + 7]);                              \
    auto r0 = __builtin_amdgcn_permlane32_swap(a0, b0, false, false); auto r1 = __builtin_amdgcn_permlane32_swap(a1, b1, false, false); \
    v4u w = {r0[0], r1[0], r0[1], r1[1]}; OUT = *reinterpret_cast<bf16x8*>(&w); } while (0)
  PK4(p0, 0, pa0); PK4(p0, 8, pa1); PK4(p1, 0, pa2); PK4(p1, 8, pa3);
#undef PK4
}
template <int MODE> __device__ __forceinline__ void qkt(f32x16& p0, f32x16& p1, const char* Ks, const bf16x8* qr, int r32, int hi, const float* bias, int lane) {
  if constexpr (MODE == 2) {
    const f32x4* bp = (const f32x4*)bias + lane;
#pragma unroll
    for (int g = 0; g < 4; ++g) { const f32x4 a = bp[g * 64], b = bp[(4 + g) * 64];
#pragma unroll
      for (int j = 0; j < 4; ++j) { p0[4 * g + j] = a[j]; p1[4 * g + j] = b[j]; } }
  } else { p0 = f32x16{}; p1 = f32x16{}; }
#pragma unroll
  for (int d0 = 0; d0 < Cfg<MODE>::ND0; ++d0) { int cb = (d0 * 16 + hi * 8) * 2;
    bf16x8 b0 = *reinterpret_cast<const bf16x8*>(Ks + KSWZ(r32, cb));
    bf16x8 b1 = *reinterpret_cast<const bf16x8*>(Ks + KSWZ(32 + r32, cb));
    p0 = __builtin_amdgcn_mfma_f32_32x32x16_bf16(b0, qr[d0], p0, 0, 0, 0);
    p1 = __builtin_amdgcn_mfma_f32_32x32x16_bf16(b1, qr[d0], p1, 0, 0, 0); }
}
__device__ __forceinline__ int v_st(int k, int c) { const int kk = (k & ~0xC) | ((k & 4) << 1) | ((k & 8) >> 1); return ((kk >> 3) * 4 + (c >> 5)) * 512 + ((kk & 7) * 32 + (c & 31)) * 2; }
__device__ __forceinline__ int v_rd_base(int lane) { return ((lane & 3) << 3) | (((lane >> 2) & 3) << 6) | (((lane >> 4) & 1) << 5) | (((lane >> 5) & 1) << 8); }
constexpr int v_rd_off(int d0, int ks, int half) { return d0 * 512 + ks * 4096 + half * 2048; }
template <int OFF> __device__ __forceinline__ s16x4 tr_read(int vb) {
  s16x4 r; asm volatile("ds_read_b64_tr_b16 %0, %1 offset:%2" : "=&v"(r) : "v"(vb), "i"(OFF) : "memory"); return r;
}
template <int D0> __device__ __forceinline__ void pv_one(f32x16& od, int vb, bf16x8 pa0, bf16x8 pa1, bf16x8 pa2, bf16x8 pa3) {
  const s16x4 l0 = tr_read<v_rd_off(D0, 0, 0)>(vb), h0 = tr_read<v_rd_off(D0, 0, 1)>(vb), l1 = tr_read<v_rd_off(D0, 1, 0)>(vb), h1 = tr_read<v_rd_off(D0, 1, 1)>(vb);
  const s16x4 l2 = tr_read<v_rd_off(D0, 2, 0)>(vb), h2 = tr_read<v_rd_off(D0, 2, 1)>(vb), l3 = tr_read<v_rd_off(D0, 3, 0)>(vb), h3 = tr_read<v_rd_off(D0, 3, 1)>(vb);
  asm volatile("s_waitcnt lgkmcnt(0)" ::: "memory"); SBAR();
#define PK(L, H) (bf16x8){L[0], L[1], L[2], L[3], H[0], H[1], H[2], H[3]}
  od = __builtin_amdgcn_mfma_f32_32x32x16_bf16(pa0, PK(l0, h0), od, 0, 0, 0);
  od = __builtin_amdgcn_mfma_f32_32x32x16_bf16(pa1, PK(l1, h1), od, 0, 0, 0);
  od = __builtin_amdgcn_mfma_f32_32x32x16_bf16(pa2, PK(l2, h2), od, 0, 0, 0);
  od = __builtin_amdgcn_mfma_f32_32x32x16_bf16(pa3, PK(l3, h3), od, 0, 0, 0);
#undef PK
}
__device__ __forceinline__ void pv_d0(f32x16* o, int vb, bf16x8 pa0, bf16x8 pa1, bf16x8 pa2, bf16x8 pa3) {
  pv_one<0>(o[0], vb, pa0, pa1, pa2, pa3); pv_one<1>(o[1], vb, pa0, pa1, pa2, pa3); pv_one<2>(o[2], vb, pa0, pa1, pa2, pa3); pv_one<3>(o[3], vb, pa0, pa1, pa2, pa3);
}

struct Tiles {
  int NT;
  int jmax;
  int jsplit, extra;
  const float* btab;
  const float* bmask; const float* bzero;
  int rlo, nrows, Rw, r0w, half;
  __device__ __forceinline__ int krow(int j) const { const int je = j < jmax ? j : jmax; return je * 64 + (je >= jsplit ? extra : 0); }
  __device__ __forceinline__ const float* bias(int j) const {
    if (j < 4) return bzero;
    const int i = j - 4, rr = rlo + i; const bool in = (i < nrows) && (rr >= r0w) && (rr < r0w + 8);
    return in ? btab + (size_t)((rr - Rw + 7) * 2 + half) * 2048 : bmask;
  }
};

template <int MODE>
__device__ __forceinline__ void attn_core(const bf16* Pb, unsigned qoff, unsigned koff, unsigned voff, const Tiles& T, int kcolB, char* lds, f32x16 (&o)[4]) {
  const int tid = opaque_tid(), wid = __builtin_amdgcn_readfirstlane(tid >> 6), lane = tid & 63, r32 = lane & 31, hi = lane >> 5;
  char* V_lds = lds; char* K_lds = lds + 2 * SHM_V;
  float* ws = (float*)(lds + WS_OFF) + wid * 64; float* li_l = ws; float* al_l = ws + 32;
  float m_reg = -1e30f, l_reg = 0; bf16x8 qr[Cfg<MODE>::ND0];
#pragma unroll
  for (int d = 0; d < 4; ++d) o[d] = f32x16{};
  const __amdgpu_buffer_rsrc_t rsrc = __builtin_amdgcn_make_buffer_rsrc((void*)Pb, 0, (int)((size_t)M * INW * 2), 0x00020000);
  { const unsigned qv = (unsigned)((wid * 32 + r32) * LDQ + hi * 8) * 2u, qs = __builtin_amdgcn_readfirstlane(qoff * 2u);
#pragma unroll
    for (int d0 = 0; d0 < Cfg<MODE>::ND0; ++d0) { const v4u w = __builtin_amdgcn_raw_buffer_load_b128(rsrc, qv + d0 * 32, qs, 0); qr[d0] = *reinterpret_cast<const bf16x8*>(&w); } }
  const int sr = tid >> 4, sc = (tid & 15) * 8, vst0 = v_st(sr, sc), vst1 = v_st(32 + sr, sc);
  const unsigned kvv = (unsigned)(sr * LDK + sc) * 2u;
  const int vb0 = (int)(uintptr_t)V_lds + v_rd_base(lane);
  struct { bf16x8 vs0, vs1, ks0, ks1; } sr_[2];
#define SLOAD(i, j) do { const unsigned k0_ = (unsigned)T.krow(j) * (unsigned)(LDK * 2), vs_ = __builtin_amdgcn_readfirstlane(voff * 2u + k0_), ks_ = __builtin_amdgcn_readfirstlane(koff * 2u + k0_); \
    v4u t0_ = __builtin_amdgcn_raw_buffer_load_b128(rsrc, kvv, vs_, 0), t1_ = __builtin_amdgcn_raw_buffer_load_b128(rsrc, kvv, vs_ + 32u * LDK * 2u, 0); \
    v4u t2_ = __builtin_amdgcn_raw_buffer_load_b128(rsrc, kvv, ks_, 0), t3_ = __builtin_amdgcn_raw_buffer_load_b128(rsrc, kvv, ks_ + 32u * LDK * 2u, 0); \
    sr_[i].vs0 = *reinterpret_cast<bf16x8*>(&t0_); sr_[i].vs1 = *reinterpret_cast<bf16x8*>(&t1_); sr_[i].ks0 = *reinterpret_cast<bf16x8*>(&t2_); sr_[i].ks1 = *reinterpret_cast<bf16x8*>(&t3_); } while (0)
#define SWRITE(b, i) do { *(bf16x8*)(V_lds + (b) * SHM_V + vst0) = sr_[i].vs0;          \
    *(bf16x8*)(V_lds + (b) * SHM_V + vst1) = sr_[i].vs1; int kc = sc * 2;               \
    *(bf16x8*)(K_lds + (b) * SHM_K + KSWZ(sr, kc)) = sr_[i].ks0;                       \
    *(bf16x8*)(K_lds + (b) * SHM_K + KSWZ(32 + sr, kc)) = sr_[i].ks1; } while (0)
#define SWAIT() asm volatile("s_waitcnt vmcnt(4)" ::: "memory")
#define RESC(a) do { if (__any((a) < 1.f)) { if (hi == 0) al_l[r32] = (a); asm volatile("s_waitcnt lgkmcnt(0)" ::: "memory"); \
    for (int d = 0; d < 4; ++d) for (int r = 0; r < 16; ++r) o[d][r] *= al_l[crow(r, hi)]; } } while (0)
  f32x16 pA0, pA1, pB0, pB1; float mnA, mnB, alA, alB; bf16x8 pa0, pa1, pa2, pa3; const int NT = T.NT;
  const char* K0 = K_lds + kcolB; const char* K1 = K_lds + SHM_K + kcolB;
  constexpr int SE = 0, SO = 1;
  SLOAD(SE, 0); asm volatile("s_waitcnt vmcnt(0)" ::: "memory"); SWRITE(0, SE); __syncthreads();
  qkt<MODE>(pA0, pA1, K0, qr, r32, hi, MODE == 2 ? T.bias(0) : nullptr, lane); partialSM<MODE>(pA0, pA1, m_reg, mnA, alA);
  SLOAD(SO, 1); if (2 < NT) SLOAD(SE, 2);
  SWAIT(); SWRITE(1, SO); __syncthreads();
  for (int j = 1; j + 1 < NT; j += 2) {
    SBAR(); qkt<MODE>(pB0, pB1, K1, qr, r32, hi, MODE == 2 ? T.bias(j) : nullptr, lane);
    finishSM(pA0, pA1, alA, l_reg, pa0, pa1, pa2, pa3); SBAR();
    SLOAD(SO, j + 2); SBAR();
    pv_d0(o, vb0, pa0, pa1, pa2, pa3); partialSM<MODE>(pB0, pB1, m_reg, mnB, alB);
    __syncthreads(); SWAIT(); SWRITE(0, SE);
    RESC(alB); __syncthreads();
    SBAR(); qkt<MODE>(pA0, pA1, K0, qr, r32, hi, MODE == 2 ? T.bias(j + 1) : nullptr, lane);
    finishSM(pB0, pB1, alB, l_reg, pa0, pa1, pa2, pa3); SBAR();
    if (j + 3 < NT) SLOAD(SE, j + 3); SBAR();
    pv_d0(o, vb0 + (int)SHM_V, pa0, pa1, pa2, pa3); partialSM<MODE>(pA0, pA1, m_reg, mnA, alA);
    __syncthreads(); SWAIT(); SWRITE(1, SO);
    RESC(alA); __syncthreads();
  }
  SBAR(); qkt<MODE>(pB0, pB1, K1, qr, r32, hi, MODE == 2 ? T.bias(NT - 1) : nullptr, lane);
  finishSM(pA0, pA1, alA, l_reg, pa0, pa1, pa2, pa3); SBAR();
  pv_d0(o, vb0, pa0, pa1, pa2, pa3); partialSM<MODE>(pB0, pB1, m_reg, mnB, alB);
  __syncthreads(); RESC(alB);
  finishSM(pB0, pB1, alB, l_reg, pa0, pa1, pa2, pa3); SBAR();
  pv_d0(o, vb0 + (int)SHM_V, pa0, pa1, pa2, pa3);
  if (hi == 0) li_l[r32] = l_reg; asm volatile("s_waitcnt lgkmcnt(0)" ::: "memory");
#pragma unroll
  for (int r = 0; r < 16; ++r) { const float rl = __builtin_amdgcn_rcpf(li_l[crow(r, hi)]);
#pragma unroll
    for (int d0 = 0; d0 < 4; ++d0) o[d0][r] *= rl; }
  __syncthreads();
#undef SLOAD
#undef SWRITE
#undef SWAIT
#undef RESC
}
__device__ __forceinline__ void store_o_bf16(const f32x16 (&o)[4], bf16* Ob, char* lds) {
  const int tid = opaque_tid(), wid = __builtin_amdgcn_readfirstlane(tid >> 6), lane = tid & 63, r32 = lane & 31, hi = lane >> 5;
  char* st = lds + OST_OFF + wid * OST_WAVE;
#pragma unroll
  for (int r = 0; r < 16; ++r) { const int row = crow(r, hi);
#pragma unroll
    for (int d0 = 0; d0 < 4; ++d0) *(unsigned short*)(st + row * OST_STRIDE + (d0 * 32 + r32) * 2) = (unsigned short)f2bf(o[d0][r]); }
  asm volatile("s_waitcnt lgkmcnt(0)" ::: "memory");
#pragma unroll
  for (int i = 0; i < 8; ++i) { const int row = i * 4 + (lane >> 4), ch = lane & 15;
    const v4u w = *(const v4u*)(st + row * OST_STRIDE + ch * 16);
    *(v4u*)(Ob + (size_t)(wid * 32 + row) * D + ch * 8) = w; }
  asm volatile("s_waitcnt lgkmcnt(0)" ::: "memory");
}
#undef KSWZ
}

struct Args { const float* in[26]; float* out; unsigned char* ws; int ph_lo, ph_hi, li, pad; };
enum { I_X = 0, I_C, I_CTX, I_CCTX, I_ADOWN, I_AUP, I_ABIAS, I_NMPRE, I_NMPOST, I_NFPRE, I_NFPOST, I_WIN, I_AQN, I_AKN, I_RPB, I_LQ1, I_LK1, I_LQ2, I_LK2, I_SUBLN, I_WGU, I_BGATE, I_WBR, I_WOUT, I_WFFI, I_WFFO };

__device__ __forceinline__ const float* inp(int i) { asm volatile("" : "+s"(i)); return ((const float* const*)__builtin_amdgcn_kernarg_segment_ptr())[i]; }
__device__ __forceinline__ float* outp() { int i = 26; asm volatile("" : "+s"(i)); return ((float* const*)__builtin_amdgcn_kernarg_segment_ptr())[i]; }
struct Frame {
    LAS unsigned char* lds; unsigned char* ws; int vcu, G;
};

__device__ __forceinline__ void transpose_item(const float* W, int K, int N, bf16* Bt, int k0, int n0, int r0, LAS float* scr, int lane) {
    const float* src = W + (size_t)k0 * N + n0 + (lane & 15) * 4;
#pragma unroll 4
    for (int i = 0; i < 16; ++i) { const int kk = 4 * i + (lane >> 4); const f32x4 v = *(const f32x4*)(src + (size_t)kk * N);
        LAS float* d = scr + kk * 65 + (lane & 15) * 4; d[0] = v[0]; d[1] = v[1]; d[2] = v[2]; d[3] = v[3]; }
    asm volatile("s_waitcnt lgkmcnt(0)" ::: "memory");
    const int c = lane & 7;
#pragma unroll
    for (int j = 0; j < 8; ++j) { const int n = (lane >> 3) + 8 * j; const LAS float* s = scr + (8 * c) * 65 + n;
        v4u o; o.x = pk2(s[0 * 65], s[1 * 65]); o.y = pk2(s[2 * 65], s[3 * 65]); o.z = pk2(s[4 * 65], s[5 * 65]); o.w = pk2(s[6 * 65], s[7 * 65]);
        *(v4u*)(Bt + (size_t)(r0 + n) * K + k0 + 8 * c) = o; }
    asm volatile("s_waitcnt lgkmcnt(0)" ::: "memory");
}
__device__ __forceinline__ void phase_p0(const Frame& F, const Args& A) {
    const int tid_ = opaque_tid(), lane_ = tid_ & 63, wave_ = __builtin_amdgcn_readfirstlane(tid_ >> 6); (void)tid_; (void)lane_; (void)wave_;
    const int gw = F.vcu * 8 + wave_, NGW = F.G * 8;
    for (int it = gw; it < 256; it += NGW) {
        const int l = it >> 6, jb = (it >> 4) & 3, kc = it & 15, j = jb * 64 + lane_;
        const float* wd = inp(I_ADOWN) + (size_t)l * D * ADAR; float acc[5] = {0.f, 0.f, 0.f, 0.f, 0.f};
        for (int k = kc * 256; k < kc * 256 + 256; ++k) { const float w = wd[(size_t)k * ADAR + j];
#pragma unroll
            for (int r = 0; r < 5; ++r) { const float cv = (r < 4) ? inp(I_C)[r * D + k] : inp(I_CCTX)[k]; acc[r] += cv * pg8::sigm(cv) * w; } }
        float* t1p = (float*)(F.ws + WS_T1P);
#pragma unroll
        for (int r = 0; r < 5; ++r) t1p[((l * 16 + kc) * 5 + r) * 256 + j] = acc[r];
    }
    LAS float* scr = (LAS float*)(F.lds + wave_ * 16640);
    constexpr int I0 = (D / 64) * (INW / 64), I1 = (GRK / 64) * (3 * D / 64), I2 = (D / 64) * (D / 64), I3 = I2, I4 = (D / 64) * (2 * DFF / 64), I5 = (DFF / 64) * (D / 64), IL = I0 + I1 + I2 + I3 + I4 + I5;
    for (int it = gw; it < DEPTH * IL; it += NGW) {
        const int l = it / IL; int r = it % IL; unsigned char* wb = F.ws + WS_W + (size_t)l * W_LAYER;
        if (r < I0) { const int nb = INW / 64; transpose_item(inp(I_WIN) + (size_t)l * D * INW, D, INW, (bf16*)(wb + W_IN), (r / nb) * 64, (r % nb) * 64, (r % nb) * 64, scr, lane_); continue; } r -= I0;
        if (r < I1) { const int nb = 3 * D / 64; transpose_item(inp(I_WGU) + (size_t)l * GRK * 3 * D, GRK, 3 * D, (bf16*)(wb + W_GATE), (r / nb) * 64, (r % nb) * 64, (r % nb) * 64, scr, lane_); continue; } r -= I1;
        if (r < I2) { const int nb = D / 64; transpose_item(inp(I_WBR) + (size_t)l * D * D, D, D, (bf16*)(wb + W_BR), (r / nb) * 64, (r % nb) * 64, (r % nb) * 64, scr, lane_); continue; } r -= I2;
        if (r < I3) { const int nb = D / 64; transpose_item(inp(I_WOUT) + (size_t)l * D * D, D, D, (bf16*)(wb + W_OUT), (r / nb) * 64, (r % nb) * 64, (r % nb) * 64, scr, lane_); continue; } r -= I3;
        if (r < I4) { const int nb = 2 * DFF / 64; const int n0 = (r % nb) * 64, hf = n0 / DFF, cc = n0 % DFF, r0 = (cc / 128) * 256 + hf * 128 + (cc % 128);
            transpose_item(inp(I_WFFI) + (size_t)l * D * 2 * DFF, D, 2 * DFF, (bf16*)(wb + W_FFI), (r / nb) * 64, n0, r0, scr, lane_); continue; } r -= I4;
        { const int nb = D / 64; transpose_item(inp(I_WFFO) + (size_t)l * DFF * D, DFF, D, (bf16*)(wb + W_FFO), (r / nb) * 64, (r % nb) * 64, (r % nb) * 64, scr, lane_); }
    }
}
__device__ __forceinline__ void phase_p1(const Frame& F, const Args& A) {
    const int tid_ = opaque_tid(), lane_ = tid_ & 63, wave_ = __builtin_amdgcn_readfirstlane(tid_ >> 6); (void)tid_; (void)lane_; (void)wave_;
    const int gw = F.vcu * 8 + wave_, NGW = F.G * 8;
    LAS float* tl = (LAS float*)(F.lds + wave_ * 8192);
    for (int it = gw; it < DEPTH * 96; it += NGW) {
        const int l = it / 96, nb = it % 96, n4 = nb * 256 + lane_ * 4;
        const float* t1p = (const float*)(F.ws + WS_T1P);
#pragma unroll
        for (int q = 0; q < 4; ++q)
#pragma unroll
            for (int r = 0; r < 5; ++r) { const int j = lane_ + 64 * q; float s = 0.f;
                for (int kc = 0; kc < 16; ++kc) s += __hip_atomic_load(t1p + ((l * 16 + kc) * 5 + r) * 256 + j, RLX_AGENT);
                tl[r * 256 + j] = s; }
        asm volatile("s_waitcnt lgkmcnt(0)" ::: "memory");
        const float* wu = inp(I_AUP) + (size_t)l * ADAR * 6 * D + n4;
        f32x4 acc[5];
#pragma unroll
        for (int r = 0; r < 5; ++r) acc[r] = (f32x4){0.f, 0.f, 0.f, 0.f};
#pragma unroll 4
        for (int j = 0; j < ADAR; ++j) { const f32x4 w = *(const f32x4*)(wu + (size_t)j * 6 * D);
#pragma unroll
            for (int r = 0; r < 5; ++r) acc[r] += w * tl[r * 256 + j]; }
        const f32x4 bv = *(const f32x4*)(inp(I_ABIAS) + (size_t)l * 6 * D + n4);
        float* mod = (float*)(F.ws + WS_MOD);
#pragma unroll
        for (int r = 0; r < 5; ++r) *(f32x4*)(mod + ((size_t)l * 5 + r) * 6 * D + n4) = acc[r] + bv;
        asm volatile("s_waitcnt lgkmcnt(0)" ::: "memory");
    }
    const int gt = F.vcu * 512 + tid_, NGT = F.G * 512;
    for (int e = gt; e < 64 * 32 + 64 * 16; e += NGT) {
        float* rp = (float*)(F.ws + WS_ROPE);
        if (e < 2048) { const int pos = e >> 5, i = e & 31; const double a = (double)pos * exp(-9.210340371976184 * (double)i / 32.0); rp[e] = (float)cos(a); rp[2048 + e] = (float)sin(a); }
        else { const int e2 = e - 2048, pos = e2 >> 4, i = e2 & 15; const double a = (double)pos * exp(-9.210340371976184 * (double)i / 16.0); rp[4096 + e2] = (float)cos(a); rp[4096 + 1024 + e2] = (float)sin(a); }
    }
    for (int e = gt; e < 4 * 8 * 15 * 2 * 2048; e += NGT) {
        const int j = e & 3, ln = (e >> 2) & 63, g = (e >> 8) & 7, half = (e >> 11) & 1, rest = e >> 12, dr = rest % 15, lh = rest / 15;
        const int qc = half * 32 + (ln & 31), hi = ln >> 5, kc = ((g < 4) ? 0 : 32) + j + 8 * (g & 3) + 4 * hi;
        int c0 = qc - 8; c0 = c0 < 0 ? 0 : (c0 > 48 ? 48 : c0);
        const bool valid = (kc >= c0) && (kc < c0 + 16);
        int idx = kc - qc + 15; idx = idx < 0 ? 0 : (idx > 30 ? 30 : idx);
        const float v = valid ? inp(I_RPB)[((size_t)lh * 15 + dr) * 31 + idx] * 11.313708498984761f : -1e30f;
        ((float*)(F.ws + WS_BIAS))[e] = v;
    }
    for (int e = gt; e < 4096; e += NGT) ((float*)(F.ws + WS_BMASK))[e] = (e < 2048) ? -1e30f : 0.f;
    if (gw == 0) {
        for (int l = 0; l < DEPTH; ++l) {
            const float a = wave_sum(inp(I_LQ1)[l * 64 + lane_] * inp(I_LK1)[l * 64 + lane_]), b = wave_sum(inp(I_LQ2)[l * 64 + lane_] * inp(I_LK2)[l * 64 + lane_]);
            const float lam_init = 0.8f - 0.6f * expf(-0.3f * (float)l);
            if (lane_ == 0) ((float*)(F.ws + WS_LAM))[l] = expf(a) - expf(b) + lam_init;
        }
    }
}
template <int MODE>
__device__ __forceinline__ void phase_rows(const Frame& F, const Args& A, const float* gpost, const float* modA  , const float* gpre, const float* modSh, const float* modSc, const bool skipctx, const bool tailsum) {
    const int tid_ = opaque_tid(), lane_ = tid_ & 63, wave_ = __builtin_amdgcn_readfirstlane(tid_ >> 6); (void)tid_; (void)lane_; (void)wave_;
    const int gw = F.vcu * 8 + wave_, NGW = F.G * 8;
    float* X = (float*)(F.ws + WS_X); const float* Y = (const float*)(F.ws + WS_Y); bf16* H = (bf16*)(F.ws + WS_H);
    for (int m = gw; m < M; m += NGW) {
        const int b = m / TPB, i = m % TPB, mr = (i < CTXL) ? 4 : b; const size_t mo = (size_t)mr * 6 * D;
        if (skipctx && i < CTXL) continue;
        f32x4 x[16];
        float* xr = X + (size_t)m * D + lane_ * 4;
        if constexpr (MODE == 0) {
            const float* src = (i < CTXL) ? inp(I_CTX) + ((size_t)b * CTXL + i) * D : inp(I_X) + ((size_t)b * SEQ + (i - CTXL)) * D;
#pragma unroll
            for (int q = 0; q < 16; ++q) { x[q] = *(const f32x4*)(src + lane_ * 4 + q * 256); *(f32x4*)(xr + q * 256) = x[q]; }
        } else {
            f32x4 y[16]; float ss = 0.f;
            if (tailsum && m >= 16384) {
                const float* yp = (const float*)(F.ws + WS_YP) + (size_t)(m - 16384) * D + lane_ * 4;
#pragma unroll
                for (int q = 0; q < 16; ++q) y[q] = *(const f32x4*)(yp + q * 256);
#pragma unroll 1
                for (int p = 1; p < 4; ++p) { const float* ypp = yp + (size_t)p * 1024 * D;
#pragma unroll
                    for (int q = 0; q < 16; ++q) y[q] += *(const f32x4*)(ypp + q * 256); }
            } else { const float* yr = Y + (size_t)m * D + lane_ * 4;
#pragma unroll
                for (int q = 0; q < 16; ++q) y[q] = *(const f32x4*)(yr + q * 256); }
#pragma unroll
            for (int q = 0; q < 16; ++q) { x[q] = *(const f32x4*)(xr + q * 256); ss += (y[q][0] * y[q][0] + y[q][1] * y[q][1]) + (y[q][2] * y[q][2] + y[q][3] * y[q][3]); }
            const float rs = 1.0f / sqrtf(wave_sum(ss) * (1.0f / D) + EPS);
#pragma unroll
            for (int q = 0; q < 16; ++q) { const f32x4 gp = *(const f32x4*)(gpost + lane_ * 4 + q * 256), ga = *(const f32x4*)(modA + mo + lane_ * 4 + q * 256);
                x[q] = x[q] + ga * ((y[q] * rs) * gp); }
            if constexpr (MODE == 2) {
                if (i >= CTXL) { float* orow = outp() + ((size_t)b * SEQ + (i - CTXL)) * D + lane_ * 4;
#pragma unroll
                    for (int q = 0; q < 16; ++q) *(f32x4*)(orow + q * 256) = x[q]; }
            } else {
#pragma unroll
                for (int q = 0; q < 16; ++q) *(f32x4*)(xr + q * 256) = x[q];
            }
        }
        if constexpr (MODE != 2) {
            float ss = 0.f;
#pragma unroll
            for (int q = 0; q < 16; ++q) ss += (x[q][0] * x[q][0] + x[q][1] * x[q][1]) + (x[q][2] * x[q][2] + x[q][3] * x[q][3]);
            const float rs = 1.0f / sqrtf(wave_sum(ss) * (1.0f / D) + EPS);
            bf16* hr = H + (size_t)m * D + lane_ * 4;
#pragma unroll
            for (int q = 0; q < 16; ++q) { const f32x4 g = *(const f32x4*)(gpre + lane_ * 4 + q * 256), sc = *(const f32x4*)(modSc + mo + lane_ * 4 + q * 256), sh = *(const f32x4*)(modSh + mo + lane_ * 4 + q * 256);
                const f32x4 h = ((x[q] * rs) * g) * (1.0f + sc) + sh;
                v2u w; w.x = pk2(h[0], h[1]); w.y = pk2(h[2], h[3]); *(v2u*)(hr + q * 256) = w; }
        }
    }
}
__device__ __forceinline__ void phase_qk(const Frame& F, const Args& A, int l) {
    const int tid_ = opaque_tid(), lane_ = tid_ & 63, wave_ = __builtin_amdgcn_readfirstlane(tid_ >> 6); (void)tid_; (void)lane_; (void)wave_;
    const int gw = F.vcu * 8 + wave_, NGW = F.G * 8;
    bf16* P = (bf16*)(F.ws + WS_PROJ); const float* rp = (const float*)(F.ws + WS_ROPE);
    const float* gq = inp(I_AQN) + l * HD; const float* gk = inp(I_AKN) + l * HD;
    for (int m = gw; m < M; m += NGW) {
        const int i = m % TPB; const bool lat = i >= CTXL; const int t = i - CTXL, prow = t >> 6, pcol = t & 63;
        bf16* row = P + (size_t)m * INW;
#pragma unroll
        for (int s = 0; s < 5; ++s) {
            const int col = s * 512 + lane_ * 8, d = col & 127;
            v4u w = *(const v4u*)(row + col);
            float v[8] = {bflo(w.x), bfhi(w.x), bflo(w.y), bfhi(w.y), bflo(w.z), bfhi(w.z), bflo(w.w), bfhi(w.w)};
            float ss = 0.f;
#pragma unroll
            for (int j = 0; j < 8; ++j) ss += v[j] * v[j];
            ss += __shfl_xor(ss, 1); ss += __shfl_xor(ss, 2); ss += __shfl_xor(ss, 4); ss += __shfl_xor(ss, 8);
            const float rs = 1.0f / sqrtf(ss * (1.0f / HD) + EPS);
            const float* g = (col < C_AK) ? gq : gk;
            const f32x4 g0 = *(const f32x4*)(g + d), g1 = *(const f32x4*)(g + d + 4);
#pragma unroll
            for (int j = 0; j < 4; ++j) { v[j] = v[j] * rs * g0[j]; v[4 + j] = v[4 + j] * rs * g1[j]; }
            if (lat) {
                const int p0 = d >> 1; const int pos = (p0 < 32) ? prow : pcol; const int fi = p0 & 31;
                const f32x4 cs = *(const f32x4*)(rp + pos * 32 + fi), sn = *(const f32x4*)(rp + 2048 + pos * 32 + fi);
#pragma unroll
                for (int j = 0; j < 4; ++j) { const float a = v[2 * j], b2 = v[2 * j + 1]; v[2 * j] = a * cs[j] - b2 * sn[j]; v[2 * j + 1] = a * sn[j] + b2 * cs[j]; }
            }
            w.x = pk2(v[0], v[1]); w.y = pk2(v[2], v[3]); w.z = pk2(v[4], v[5]); w.w = pk2(v[6], v[7]);
            *(v4u*)(row + col) = w;
        }
        if (lat) {
#pragma unroll
            for (int s = 0; s < 4; ++s) {
                const int col = C_CQ + s * 512 + lane_ * 8, d = col & 63;
                v4u w = *(const v4u*)(row + col);
                float v[8] = {bflo(w.x), bfhi(w.x), bflo(w.y), bfhi(w.y), bflo(w.z), bfhi(w.z), bflo(w.w), bfhi(w.w)};
                const int p0 = d >> 1; const int pos = (p0 < 16) ? prow : pcol; const int fi = p0 & 15;
                const f32x4 cs = *(const f32x4*)(rp + 4096 + pos * 16 + fi), sn = *(const f32x4*)(rp + 4096 + 1024 + pos * 16 + fi);
#pragma unroll
                for (int j = 0; j < 4; ++j) { const float a = v[2 * j], b2 = v[2 * j + 1]; v[2 * j] = a * cs[j] - b2 * sn[j]; v[2 * j + 1] = a * sn[j] + b2 * cs[j]; }
                w.x = pk2(v[0], v[1]); w.y = pk2(v[2], v[3]); w.z = pk2(v[4], v[5]); w.w = pk2(v[6], v[7]);
                *(v4u*)(row + col) = w;
            }
        }
    }
}
__device__ __forceinline__ void phase_attn(const Frame& F, const Args& A, int l) {
    const int tid_ = opaque_tid(), lane_ = tid_ & 63, wave_ = __builtin_amdgcn_readfirstlane(tid_ >> 6); (void)tid_; (void)lane_; (void)wave_;
    char* lds = (char*)F.lds;
    const bf16* P = (const bf16*)(F.ws + WS_PROJ); bf16* MIX = (bf16*)(F.ws + WS_MIX);
    const bool last = (l == DEPTH - 1);
    if (PHM & 0x1000) {
        const int nU = 1024 + (last ? 0 : 96);
        for (int u = F.vcu; u < nU; u += F.G) {
            int b, qrow, kcol, vcol, qcol, ocol, nt;
            if (u < 1024) { const int qb = u & 15, hq = (u >> 4) & 15; b = u >> 8; qrow = CTXL + qb * 256; qcol = C_AQ + hq * HD; kcol = C_AK + (hq >> 2) * HD; vcol = C_AV + (hq >> 2) * HD; ocol = hq * HD; nt = TPB / 64; }
            else if (u < 1088) { const int v = u - 1024, hq = v & 15; b = v >> 4; qrow = 0; qcol = C_AQ + hq * HD; kcol = C_AK + (hq >> 2) * HD; vcol = C_AV + (hq >> 2) * HD; ocol = hq * HD; nt = CTXL / 64; }
            else { const int v = u - 1088, hb = v & 7; b = v >> 3; qrow = 0; qcol = C_BQ + hb * HD; kcol = C_BK + hb * HD; vcol = C_BV + hb * HD; ocol = 2048 + hb * HD; nt = CTXL / 64; }
            att::Tiles T; T.NT = nt; T.jmax = nt - 1; T.jsplit = 1 << 30; T.extra = 0; T.btab = nullptr; T.bmask = nullptr; T.bzero = nullptr; T.rlo = T.nrows = T.Rw = T.r0w = T.half = 0;
            const size_t rb = (size_t)b * TPB;
            f32x16 o[4];
            att::attn_core<0>(P, (unsigned)((rb + qrow) * INW + qcol), (unsigned)(rb * INW + kcol), (unsigned)(rb * INW + vcol), T, 0, lds, o);
            att::store_o_bf16(o, MIX + (rb + qrow) * D + ocol, lds);
        }
    }
    if (PHM & 0x2000) {
        for (int u = F.vcu; u < 512; u += F.G) {
            const int qb = u & 15, hb = (u >> 4) & 7, b = u >> 7;
            int rlo = 4 * qb - 4; rlo = rlo < 0 ? 0 : (rlo > 56 ? 56 : rlo);
            int rh = 4 * qb + 3 - 4; rh = rh < 0 ? 0 : (rh > 56 ? 56 : rh); const int nrows = rh + 8 - rlo;
            att::Tiles T; T.NT = (4 + nrows + 1) & ~1; T.jmax = 4 + nrows - 1; T.jsplit = 4; T.extra = rlo * 64;
            T.btab = (const float*)(F.ws + WS_BIAS) + (size_t)(l * 8 + hb) * 15 * 2 * 2048; T.bmask = (const float*)(F.ws + WS_BMASK); T.bzero = T.bmask + 2048;
            T.rlo = rlo; T.nrows = nrows; T.Rw = 4 * qb + (wave_ >> 1); { int r0 = T.Rw - 4; T.r0w = r0 < 0 ? 0 : (r0 > 56 ? 56 : r0); } T.half = wave_ & 1;
            const size_t rb = (size_t)b * TPB; const int qrow = CTXL + qb * 256;
            f32x16 o[4];
            att::attn_core<2>(P, (unsigned)((rb + qrow) * INW + C_BQ + hb * HD), (unsigned)(rb * INW + C_BK + hb * HD), (unsigned)(rb * INW + C_BV + hb * HD), T, 0, lds, o);
            att::store_o_bf16(o, MIX + (rb + qrow) * D + 2048 + hb * HD, lds);
        }
    }
    if (PHM & 0x4000) {
        const float lam = __hip_atomic_load((const float*)(F.ws + WS_LAM) + l, RLX_AGENT);
        const float lam_init = 0.8f - 0.6f * expf(-0.3f * (float)l);
        float* scr = (float*)(F.ws + WS_Y) + (size_t)blockIdx.x * 32768 + wave_ * 4096 + lane_ * 64;
        const float* gs = inp(I_SUBLN) + l * HD;
        const int nU = 512 + (last ? 0 : 32);
        for (int u = F.vcu; u < nU; u += F.G) {
            int b, hc, qrow, nt;
            if (u < 512) { const int qb = u & 15; hc = (u >> 4) & 7; b = u >> 7; qrow = CTXL + qb * 256; nt = TPB / 64; }
            else { const int v = u - 512; hc = v & 7; b = v >> 3; qrow = 0; nt = CTXL / 64; }
            att::Tiles T; T.NT = nt; T.jmax = nt - 1; T.jsplit = 1 << 30; T.extra = 0; T.btab = nullptr; T.bmask = nullptr; T.bzero = nullptr; T.rlo = T.nrows = T.Rw = T.r0w = T.half = 0;
            const size_t rb = (size_t)b * TPB;
#pragma unroll 1
            for (int comp = 0; comp < 2; ++comp) {
                f32x16 o[4];
                att::attn_core<1>(P, (unsigned)((rb + qrow) * INW + C_CQ + hc * HD + comp * 64), (unsigned)(rb * INW + C_CK + hc * HD), (unsigned)(rb * INW + C_CV + hc * HD), T, comp * 128, lds, o);
                if (comp == 0) {
#pragma unroll
                    for (int d0 = 0; d0 < 4; ++d0)
#pragma unroll
                        for (int q = 0; q < 4; ++q) *(f32x4*)(scr + d0 * 16 + q * 4) = (f32x4){o[d0][4 * q], o[d0][4 * q + 1], o[d0][4 * q + 2], o[d0][4 * q + 3]};
                } else {
                    const int r32 = lane_ & 31;
#pragma unroll
                    for (int d0 = 0; d0 < 4; ++d0)
#pragma unroll
                        for (int q = 0; q < 4; ++q) { const f32x4 t = *(const f32x4*)(scr + d0 * 16 + q * 4);
#pragma unroll
                            for (int j = 0; j < 4; ++j) o[d0][4 * q + j] = t[j] - lam * o[d0][4 * q + j]; }
                    float gv[4];
#pragma unroll
                    for (int d0 = 0; d0 < 4; ++d0) gv[d0] = gs[d0 * 32 + r32] * (1.0f - lam_init);
#pragma unroll
                    for (int r = 0; r < 16; ++r) { float ss = (o[0][r] * o[0][r] + o[1][r] * o[1][r]) + (o[2][r] * o[2][r] + o[3][r] * o[3][r]);
                        ss += __shfl_xor(ss, 1); ss += __shfl_xor(ss, 2); ss += __shfl_xor(ss, 4); ss += __shfl_xor(ss, 8); ss += __shfl_xor(ss, 16);
                        const float rs = 1.0f / sqrtf(ss * (1.0f / HD) + EPS);
#pragma unroll
                        for (int d0 = 0; d0 < 4; ++d0) o[d0][r] = o[d0][r] * rs * gv[d0]; }
                    att::store_o_bf16(o, MIX + (rb + qrow) * D + 3072 + hc * HD, lds);
                }
            }
        }
    }
}

constexpr int NPH_LAYER = 9;
constexpr int NPHASES = 3 + DEPTH * NPH_LAYER;

__global__ void __launch_bounds__(512, 2) trunk_fwd(Args args) {
    extern __shared__ __attribute__((aligned(16))) unsigned char lds_raw[];
    Frame F;
    F.lds = (LAS unsigned char*)lds_raw; F.ws = args.ws;
    F.G = gridDim.x; { const int bx = blockIdx.x; F.vcu = (F.G % 8 == 0) ? (bx % 8) * (F.G / 8) + bx / 8 : bx; }
    volatile LAS unsigned* MISC = (volatile LAS unsigned*)(F.lds + MISC_OFF);
    if (threadIdx.x < 64) MISC[threadIdx.x] = 0u;
    __syncthreads();
    unsigned* ctl = (unsigned*)(args.ws + WS_CTL);
    XcdBarrier bar; bar.bar = ctl + CW_BAR; bar.x = 0; bar.st = nullptr;
    const int lo = args.ph_lo, hi = args.ph_hi;
    if (hi - lo > 1) bar = xcd_barrier_post(ctl + CW_BAR + args.li * XCD_BAR_WORDS, MISC + 8);
#define IN(k) (lo <= (k) && (k) < hi)
#define SEAM(k) do { if (IN(k) && IN((k) + 1)) xcd_barrier(bar); } while (0)
    const float* MOD = (const float*)(args.ws + WS_MOD);

    if ((PHM & 1) && IN(0)) { phase_p0(F, args); } SEAM(0);
    if ((PHM & 2) && IN(1)) { phase_p1(F, args); } SEAM(1);
    if ((PHM & 4) && IN(2)) { _Pragma("unroll 1") for (int rep_ = 0; rep_ < ((PROBE_DUP >> 12) & 1 ? 9 : 1); ++rep_) phase_rows<0>(F, args, nullptr, nullptr, inp(I_NMPRE), MOD + 0 * D, MOD + 1 * D, false, false); } SEAM(2);

    for (int l = 0; l < DEPTH; ++l) {
        const int pb = 3 + l * NPH_LAYER;
        unsigned char* wb = args.ws + WS_W + (size_t)l * W_LAYER;
        const float* modl = MOD + (size_t)l * 5 * 6 * D;
        const bool last = (l == DEPTH - 1);
        if ((PHM & 8) && IN(pb + 0)) {
_Pragma("unroll 1") for (int rep_ = 0; rep_ < DUPN(0); ++rep_) {
            pg8::Gemm g{(const bf16*)(args.ws + WS_H), (const bf16*)(wb + W_IN), M, INW, D, D}; pg8::Sched S; if (last) S.init(64, INW / 256, D / 64, F.G, (int)blockIdx.x, 1, 0, 1, 0, 1); else S.init(68, INW / 256, D / 64, F.G, (int)blockIdx.x, 0, 0, 1, 0, 0);
            pg8::EpiBf16<0> E{(bf16*)(args.ws + WS_PROJ), INW, nullptr};
            pg8::gemm_phase<pg8::EpiBf16<0>, pg8::Sched>(F.lds, g, S, E);
        }
        } SEAM(pb + 0);
        if ((PHM & 16) && IN(pb + 1)) { phase_qk(F, args, l); } SEAM(pb + 1);
        if ((PHM & 32) && IN(pb + 2)) {
_Pragma("unroll 1") for (int rep_ = 0; rep_ < DUPN(2); ++rep_) {
            phase_attn(F, args, l);
            __syncthreads();
            if (PHM & 0x8000) {
            pg8::Gemm g{(const bf16*)(args.ws + WS_PROJ) + C_GL, (const bf16*)(wb + W_GATE), M, 3 * D, GRK, INW}; pg8::Sched S; S.init(last ? 64 : 68, 3 * D / 256, GRK / 64, F.G, (int)blockIdx.x, last ? 1 : 0, 0, 1, 0, 0);
            pg8::EpiBf16<2> E{(bf16*)(args.ws + WS_G), 3 * D, inp(I_BGATE) + (size_t)l * 3 * D};
            pg8::gemm_phase<pg8::EpiBf16<2>, pg8::Sched>(F.lds, g, S, E); }
        }
        } SEAM(pb + 2);
        if ((PHM & 64) && IN(pb + 3)) {
_Pragma("unroll 1") for (int rep_ = 0; rep_ < DUPN(3); ++rep_) {
            pg8::Gemm g{(const bf16*)(args.ws + WS_MIX), (const bf16*)(wb + W_BR), M, D, D, D}; pg8::Sched S; S.init(last ? 64 : 68, D / 256, D / 64, F.G, (int)blockIdx.x, last ? 1 : 0, 0, 1, 0, 0);
            pg8::EpiHorner E{(bf16*)(args.ws + WS_MRG), D, (const bf16*)(args.ws + WS_G)};
            pg8::gemm_phase<pg8::EpiHorner, pg8::Sched>(F.lds, g, S, E);
        }
        } SEAM(pb + 3);
        if ((PHM & 128) && IN(pb + 4)) {
_Pragma("unroll 1") for (int rep_ = 0; rep_ < DUPN(4); ++rep_) {
            pg8::Gemm g{(const bf16*)(args.ws + WS_MRG), (const bf16*)(wb + W_OUT), M, D, D, D}; pg8::Sched S; S.init(64, D / 256, D / 64, F.G, (int)blockIdx.x, last ? 1 : 0, last ? 0 : 4, 4, 64, 0);
            pg8::EpiF32 E{(float*)(args.ws + WS_Y), D, (float*)(args.ws + WS_YP), 64, (size_t)1024 * D};
            pg8::gemm_phase<pg8::EpiF32, pg8::Sched>(F.lds, g, S, E);
        }
        } SEAM(pb + 4);
        if ((PHM & 256) && IN(pb + 5)) { phase_rows<1>(F, args, inp(I_NMPOST) + (size_t)l * D, modl + 2 * D, inp(I_NFPRE) + (size_t)l * D, modl + 3 * D, modl + 4 * D, last, !last); } SEAM(pb + 5);
        if ((PHM & 512) && IN(pb + 6)) {
_Pragma("unroll 1") for (int rep_ = 0; rep_ < DUPN(6); ++rep_) {
            pg8::Gemm g{(const bf16*)(args.ws + WS_H), (const bf16*)(wb + W_FFI), M, 2 * DFF, D, D}; pg8::Sched S; S.init(last ? 64 : 68, 2 * DFF / 256, D / 64, F.G, (int)blockIdx.x, last ? 1 : 0, 0, 1, 0, 0);
            pg8::EpiSwiGLU E{(bf16*)(args.ws + WS_ACT), DFF};
            pg8::gemm_phase<pg8::EpiSwiGLU, pg8::Sched>(F.lds, g, S, E);
        }
        } SEAM(pb + 6);
        if ((PHM & 1024) && IN(pb + 7)) {
_Pragma("unroll 1") for (int rep_ = 0; rep_ < DUPN(7); ++rep_) {
            pg8::Gemm g{(const bf16*)(args.ws + WS_ACT), (const bf16*)(wb + W_FFO), M, D, DFF, DFF}; pg8::Sched S; S.init(64, D / 256, DFF / 64, F.G, (int)blockIdx.x, last ? 1 : 0, last ? 0 : 4, 4, 64, 0);
            pg8::EpiF32 E{(float*)(args.ws + WS_Y), D, (float*)(args.ws + WS_YP), 64, (size_t)1024 * D};
            pg8::gemm_phase<pg8::EpiF32, pg8::Sched>(F.lds, g, S, E);
        }
        } SEAM(pb + 7);
        if ((PHM & 2048) && IN(pb + 8)) {
            if (l < DEPTH - 1) phase_rows<1>(F, args, inp(I_NFPOST) + (size_t)l * D, modl + 5 * D, inp(I_NMPRE) + (size_t)(l + 1) * D, modl + 5 * 6 * D + 0 * D, modl + 5 * 6 * D + 1 * D, false, true);
            else phase_rows<2>(F, args, inp(I_NFPOST) + (size_t)l * D, modl + 5 * D, nullptr, nullptr, nullptr, true, false);
        } SEAM(pb + 8);
    }
#undef IN
#undef SEAM
}

extern "C" void kernel_launch(void* const* d_in, const int* in_sizes, int n_in, void* d_out, int out_size, void* d_ws, size_t ws_size, hipStream_t stream) {
    static int grid = 0;
    if (grid == 0) {
        if (n_in != 26 || in_sizes[0] != NB * SEQ * D || out_size != NB * SEQ * D || ws_size < WS_END) { fprintf(stderr, "kernel_launch: shape mismatch (n_in %d, in0 %d, out %d, ws %zu < %zu)\n", n_in, n_in > 0 ? in_sizes[0] : -1, out_size, ws_size, (size_t)WS_END); grid = -1; return; }
        int dev = 0, cus = 0, per_cu = 0;
        if (hipGetDevice(&dev) != hipSuccess || hipDeviceGetAttribute(&cus, hipDeviceAttributeMultiprocessorCount, dev) != hipSuccess) { grid = -1; return; }
        if (hipFuncSetAttribute((const void*)trunk_fwd, hipFuncAttributeMaxDynamicSharedMemorySize, LDS_BYTES) != hipSuccess) { fprintf(stderr, "kernel_launch: hipFuncSetAttribute failed\n"); grid = -1; return; }
        if (hipOccupancyMaxActiveBlocksPerMultiprocessor(&per_cu, (const void*)trunk_fwd, 512, LDS_BYTES) != hipSuccess || per_cu < 1) fprintf(stderr, "kernel_launch: occupancy query says %d\n", per_cu);
        (void)hipGetLastError();
        grid = cus;
    }
    if (grid < 0) return;
    (void)hipMemsetAsync((char*)d_ws + WS_CTL, 0, CTL_ZERO_BYTES, stream);
    Args a{};
    for (int i = 0; i < 26; ++i) a.in[i] = (const float*)d_in[i];
    a.out = (float*)d_out; a.ws = (unsigned char*)d_ws; a.pad = 0;
#if MK_PER_PHASE
    for (int p = 0; p < NPHASES; ++p) { a.ph_lo = p; a.ph_hi = p + 1; a.li = 0; hipLaunchKernelGGL(trunk_fwd, dim3(grid), dim3(512), LDS_BYTES, stream, a); }
#else
    a.ph_lo = 0; a.ph_hi = NPHASES; a.li = 0; hipLaunchKernelGGL(trunk_fwd, dim3(grid), dim3(512), LDS_BYTES, stream, a);
#endif
    const hipError_t le = hipPeekAtLastError();
    if (le != hipSuccess) fprintf(stderr, "kernel_launch: launch failed: %s\n", hipGetErrorName(le));
}
```

```cpp
#include <hip/hip_runtime.h>
#include <cstdio>
#include <cstdint>

#ifndef PHM
#define PHM 0xffff
#endif
#ifndef PROBE_DUP
#define PROBE_DUP 0
#endif
#define DUPN(k) ((PROBE_DUP >> (k)) & 1 ? 2 : 1)
#ifndef MK_PER_PHASE
#define MK_PER_PHASE 0
#endif

__device__ __forceinline__ int opaque_tid() { int t = threadIdx.x; asm volatile("" : "+v"(t)); return t; }
namespace pg8 {
#define PG8_LAS __attribute__((address_space(3)))
typedef unsigned short bf16_t;
typedef short bf16x8 __attribute__((ext_vector_type(8)));
typedef float f32x4 __attribute__((ext_vector_type(4)));
typedef unsigned u32x4 __attribute__((ext_vector_type(4)));
constexpr int BM = 256, BK = 64, HALF = 128, HTB = HALF * BK * 2, STAGE_BYTES = 8 * HTB, NXCD = 8, WGM = 8;

__host__ __device__ __forceinline__ int lds_byte(int r, int c) { const int st = (r >> 4) * 2 + (c >> 5), rr = r & 15, cc = c & 31, ob = rr * 64 + cc * 2; return st * 1024 + (ob ^ (((ob >> 9) & 1) << 5)); }
__host__ __device__ __forceinline__ void stage_rc(int b, int& R, int& C) { const int st = b / 1024, sb = b % 1024, swz = sb ^ (((sb >> 9) & 1) << 5); R = (st >> 1) * 16 + swz / 64; C = (st & 1) * 32 + (swz % 64) / 2; }
__host__ __device__ __forceinline__ int perm32(int rho) { const int n = rho >> 4, i = rho & 15; return 8 * (i >> 2) + 4 * n + (i & 3); }

struct Unit { int pm, pn, kt0, nt, part; };
struct Gemm { const bf16_t* A; const bf16_t* Bt; int M, N, K, lda; };

struct Sched {
    int nMl, nN, nmain, G, c, NT, ntail, ksplit, tp0, pmode, xmode;
    __device__ __forceinline__ void init(int nMl_, int nN_, int NT_, int G_, int c_, int pmode_, int ntailp, int ksplit_, int tp0_, int xmode_) {
        nMl = nMl_; nN = nN_; nmain = nMl * nN; G = G_; c = c_; NT = NT_; ntail = ntailp * nN_; ksplit = ksplit_; tp0 = tp0_; pmode = pmode_; xmode = xmode_; }
    __device__ __forceinline__ bool next(int i, Unit& u) const {
        const int L = i * G + c;
        int pm = 0, pn = 0, kt0 = 0, nt = NT, part = -1; bool ok = true;
        const int s1 = L - nmain, s2 = s1 - ntail * ksplit;
        if (L < nmain) {
            int wgid = L; { const int q = nmain / NXCD, r = nmain % NXCD, xcd = wgid % NXCD, off = wgid / NXCD; wgid = (xcd < r ? xcd * (q + 1) : r * (q + 1) + (xcd - r) * q) + off; }
            const int nig = WGM * nN, gid = wgid / nig, fm = gid * WGM, gsz = (nMl - fm) < WGM ? (nMl - fm) : WGM;
            const int lp = fm + ((wgid % nig) % gsz); pn = (wgid % nig) / gsz; pm = pmode ? (lp >> 4) * 17 + 1 + (lp & 15) : lp;
        } else if (s2 < 0) {
            const int tile = s1 / ksplit, p = s1 % ksplit, q = NT / ksplit, p1 = p + 1; pm = tp0 + tile / nN; pn = tile % nN; part = p;
            const int st = p * q + ((q & 1) ? (p <= ksplit / 2 ? p : ksplit - p) : 0), en = p1 * q + ((q & 1) ? (p1 <= ksplit / 2 ? p1 : ksplit - p1) : 0); kt0 = st; nt = en - st;
        } else if (xmode && s2 < 80) {
            const int j = s2 % 20; pm = 17 * (s2 / 20); pn = (j < 4) ? 8 + j : (j < 12 ? 16 + (j - 4) : 28 + (j - 12));
        } else ok = false;
        u.pm = pm; u.pn = pn; u.kt0 = kt0; u.nt = nt; u.part = part;
        return ok;
    }
    __device__ __forceinline__ void a_ready(const Unit&) const {}
    __device__ __forceinline__ void done(const Unit&) const {}
};

__device__ __forceinline__ unsigned cvt_pk_bf16(float lo, float hi) { unsigned r; asm volatile("v_cvt_pk_bf16_f32 %0, %1, %2" : "=v"(r) : "v"(lo), "v"(hi)); return r; }
__device__ __forceinline__ float sigm(float x) { return __builtin_amdgcn_rcpf(1.0f + __builtin_amdgcn_exp2f(-1.4426950408889634f * x)); }
__device__ __forceinline__ f32x4 bf4lo(unsigned a, unsigned b) { return (f32x4){__uint_as_float(a << 16), __uint_as_float(a & 0xffff0000u), __uint_as_float(b << 16), __uint_as_float(b & 0xffff0000u)}; }

template <int ACT> struct EpiBf16 {
    static constexpr bool PERM = true, AFTER_DRAIN = false, HORNER = false;
    bf16_t* O; int ldc; const float* bias;
    __device__ __forceinline__ void mid(f32x4 (&)[2][2][4][2], const Unit&, int, int, int, int, int) const {}
    __device__ __forceinline__ void operator()(const f32x4 (&acc)[2][2][4][2], const Unit& u, int wr, int wc, int fr, int fq) const {
        const int row0 = u.pm * BM + wr * 64 + fr; const int col0 = u.pn * BM + wc * 32 + 8 * fq;
        f32x4 bv[2][2];
#pragma unroll
        for (int bj = 0; bj < 2; ++bj)
#pragma unroll
            for (int n = 0; n < 2; ++n) bv[bj][n] = (ACT == 2) ? *(const f32x4*)(bias + col0 + bj * HALF + 4 * n) : (f32x4){0.f, 0.f, 0.f, 0.f};
#pragma unroll
        for (int ai = 0; ai < 2; ++ai)
#pragma unroll
            for (int m = 0; m < 4; ++m) { bf16_t* rowp = O + (size_t)(row0 + ai * HALF + m * 16) * ldc + col0;
#pragma unroll
                for (int bj = 0; bj < 2; ++bj) { f32x4 v0 = acc[ai][bj][m][0] + bv[bj][0], v1 = acc[ai][bj][m][1] + bv[bj][1];
                    if (ACT == 2) {
#pragma unroll
                        for (int j = 0; j < 4; ++j) { v0[j] = fmaxf(sigm(v0[j]), 1e-12f); v1[j] = fmaxf(sigm(v1[j]), 1e-12f); } }
                    u32x4 w; w.x = cvt_pk_bf16(v0[0], v0[1]); w.y = cvt_pk_bf16(v0[2], v0[3]); w.z = cvt_pk_bf16(v1[0], v1[1]); w.w = cvt_pk_bf16(v1[2], v1[3]);
                    *(u32x4*)(rowp + bj * HALF) = w; } }
    }
};
struct EpiSwiGLU {
    static constexpr bool PERM = true, AFTER_DRAIN = false, HORNER = false;
    bf16_t* O; int ldc;
    __device__ __forceinline__ void mid(f32x4 (&)[2][2][4][2], const Unit&, int, int, int, int, int) const {}
    __device__ __forceinline__ void operator()(const f32x4 (&acc)[2][2][4][2], const Unit& u, int wr, int wc, int fr, int fq) const {
        const int row0 = u.pm * BM + wr * 64 + fr; const int col0 = u.pn * HALF + wc * 32 + 8 * fq;
#pragma unroll
        for (int ai = 0; ai < 2; ++ai)
#pragma unroll
            for (int m = 0; m < 4; ++m) { bf16_t* rowp = O + (size_t)(row0 + ai * HALF + m * 16) * ldc + col0;
                f32x4 g0 = acc[ai][0][m][0], g1 = acc[ai][0][m][1]; const f32x4 u0 = acc[ai][1][m][0], u1 = acc[ai][1][m][1];
#pragma unroll
                for (int j = 0; j < 4; ++j) { g0[j] = g0[j] * sigm(g0[j]) * u0[j]; g1[j] = g1[j] * sigm(g1[j]) * u1[j]; }
                u32x4 w; w.x = cvt_pk_bf16(g0[0], g0[1]); w.y = cvt_pk_bf16(g0[2], g0[3]); w.z = cvt_pk_bf16(g1[0], g1[1]); w.w = cvt_pk_bf16(g1[2], g1[3]);
                *(u32x4*)rowp = w; }
    }
};
struct EpiY {
    static constexpr bool PERM = true, AFTER_DRAIN = false, HORNER = false;
    bf16_t* Y; int ldc; float* Cp; int tp0; size_t pstride;
    __device__ __forceinline__ void mid(f32x4 (&)[2][2][4][2], const Unit&, int, int, int, int, int) const {}
    __device__ __forceinline__ void operator()(const f32x4 (&acc)[2][2][4][2], const Unit& u, int wr, int wc, int fr, int fq) const {
        const int col0 = u.pn * BM + wc * 32 + 8 * fq; const int rowl = wr * 64 + fr;
        if (u.part < 0) {
            bf16_t* base = Y + (size_t)(u.pm * BM + rowl) * ldc + col0;
#pragma unroll
            for (int ai = 0; ai < 2; ++ai)
#pragma unroll
                for (int m = 0; m < 4; ++m) { bf16_t* rowp = base + (size_t)(ai * HALF + m * 16) * ldc;
#pragma unroll
                    for (int bj = 0; bj < 2; ++bj) { const f32x4 v0 = acc[ai][bj][m][0], v1 = acc[ai][bj][m][1];
                        u32x4 w; w.x = cvt_pk_bf16(v0[0], v0[1]); w.y = cvt_pk_bf16(v0[2], v0[3]); w.z = cvt_pk_bf16(v1[0], v1[1]); w.w = cvt_pk_bf16(v1[2], v1[3]);
                        *(u32x4*)(rowp + bj * HALF) = w; } }
        } else {
            float* base = Cp + (size_t)u.part * pstride + (size_t)((u.pm - tp0) * BM + rowl) * ldc + col0;
#pragma unroll
            for (int ai = 0; ai < 2; ++ai)
#pragma unroll
                for (int m = 0; m < 4; ++m) { float* rowp = base + (size_t)(ai * HALF + m * 16) * ldc;
#pragma unroll
                    for (int bj = 0; bj < 2; ++bj) { *(f32x4*)(rowp + bj * HALF) = acc[ai][bj][m][0]; *(f32x4*)(rowp + bj * HALF + 4) = acc[ai][bj][m][1]; } }
        }
    }
};
struct EpiHorner {
    static constexpr bool PERM = true, AFTER_DRAIN = false, HORNER = true;
    bf16_t* O; int ldc; const bf16_t* G;
    __device__ __forceinline__ void mid(f32x4 (&acc)[2][2][4][2], const Unit& u, int t, int wr, int wc, int fr, int fq) const {
        const __amdgpu_buffer_rsrc_t rs = __builtin_amdgcn_make_buffer_rsrc((void*)G, 0, (int)(17408u * 12288u * 2u), 0x00020000);
        const unsigned vo = (unsigned)((wr * 64 + fr) * 12288 + wc * 32 + 8 * fq) * 2u;
        const unsigned so0 = (unsigned)__builtin_amdgcn_readfirstlane((u.pm * BM * 12288 + u.pn * BM + ((t == 32) ? 0 : 4096)) * 2);
#pragma unroll
        for (int ai = 0; ai < 2; ++ai)
#pragma unroll
            for (int m = 0; m < 4; ++m)
#pragma unroll
                for (int bj = 0; bj < 2; ++bj) { const unsigned so = so0 + (unsigned)(((ai * HALF + m * 16) * 12288 + bj * HALF) * 2);
                    const u32x4 a = __builtin_amdgcn_raw_buffer_load_b128(rs, vo, so, 0), b = __builtin_amdgcn_raw_buffer_load_b128(rs, vo, so + 8192u, 0);
                    const f32x4 a0 = bf4lo(a.x, a.y), a1 = bf4lo(a.z, a.w), b0 = bf4lo(b.x, b.y), b1 = bf4lo(b.z, b.w);
#pragma unroll
                    for (int j = 0; j < 4; ++j) { acc[ai][bj][m][0][j] *= a0[j] * __builtin_amdgcn_rcpf(b0[j]); acc[ai][bj][m][1][j] *= a1[j] * __builtin_amdgcn_rcpf(b1[j]); }
                    if (bj) asm volatile("" ::: "memory"); }
    }
    __device__ __forceinline__ void operator()(const f32x4 (&acc)[2][2][4][2], const Unit& u, int wr, int wc, int fr, int fq) const {
        const __amdgpu_buffer_rsrc_t rs = __builtin_amdgcn_make_buffer_rsrc((void*)G, 0, (int)(17408u * 12288u * 2u), 0x00020000);
        const unsigned vo = (unsigned)((wr * 64 + fr) * 12288 + wc * 32 + 8 * fq) * 2u;
        const unsigned so0 = (unsigned)__builtin_amdgcn_readfirstlane((u.pm * BM * 12288 + u.pn * BM + 8192) * 2);
        const int row0 = u.pm * BM + wr * 64 + fr; const int col0 = u.pn * BM + wc * 32 + 8 * fq;
#pragma unroll
        for (int ai = 0; ai < 2; ++ai)
#pragma unroll
            for (int m = 0; m < 4; ++m) { bf16_t* rowp = O + (size_t)(row0 + ai * HALF + m * 16) * ldc + col0;
#pragma unroll
                for (int bj = 0; bj < 2; ++bj) { const unsigned so = so0 + (unsigned)(((ai * HALF + m * 16) * 12288 + bj * HALF) * 2);
                    const u32x4 c = __builtin_amdgcn_raw_buffer_load_b128(rs, vo, so, 0); const f32x4 v0 = acc[ai][bj][m][0] * bf4lo(c.x, c.y), v1 = acc[ai][bj][m][1] * bf4lo(c.z, c.w);
                    u32x4 w; w.x = cvt_pk_bf16(v0[0], v0[1]); w.y = cvt_pk_bf16(v0[2], v0[3]); w.z = cvt_pk_bf16(v1[0], v1[1]); w.w = cvt_pk_bf16(v1[2], v1[3]);
                    *(u32x4*)(rowp + bj * HALF) = w; }
                asm volatile("" ::: "memory"); }
    }
};

template <class Epi, class Sched_, bool ALIGN_EPI = true, bool SP2 = true>
__device__ __forceinline__ void gemm_phase(PG8_LAS unsigned char* lds, const Gemm g, const Sched_& S, const Epi& E) {
    const int tid = opaque_tid(), wid = __builtin_amdgcn_readfirstlane(tid >> 6), lane = tid & 63, wr = wid >> 2, wc = wid & 3, fr = lane & 15, fq = lane >> 4;
    const int K = g.K;
    unsigned voffA[2], voffB[2];
#pragma unroll
    for (int i = 0; i < 2; ++i) { int R, C; stage_rc(tid * 16 + i * 8192, R, C); const int Rb = Epi::PERM ? ((R & ~31) + perm32(R & 31)) : R;
        voffA[i] = (unsigned)(R * g.lda + C) * 2u; voffB[i] = (unsigned)(Rb * K + C) * 2u; }
    const size_t kstep = (size_t)(BK * 2);
    const size_t hstepB = (size_t)HALF * K * 2, hstepA = (size_t)HALF * g.lda * 2;
    const size_t tstepB = 2 * hstepB, tstepA = 2 * hstepA;
    const unsigned ldsw = (unsigned)wid * 1024u;
    const int aoff = lds_byte(wr * 64 + fr, fq * 8), boff = lds_byte(wc * 32 + fr, fq * 8);
#define PG8_SA(b, h) (((b) * 2 + (h)) * HTB)
#define PG8_SB(b, h) ((4 + (b) * 2 + (h)) * HTB)
#define PG8_STAGE(bufoff, gbase, voff) do { _Pragma("unroll") for (int _i = 0; _i < 2; ++_i) \
        __builtin_amdgcn_global_load_lds((const unsigned*)((const char*)(gbase) + (voff)[_i]), (PG8_LAS unsigned*)(lds + (bufoff) + ldsw + _i * 8192), 16, 0, 0); } while (0)
#define PG8_LDA(dst, b, h) do { _Pragma("unroll") for (int m = 0; m < 4; ++m) _Pragma("unroll") for (int k = 0; k < 2; ++k) dst[m][k] = *(const PG8_LAS bf16x8*)(lds + PG8_SA(b, h) + aoff + m * 2048 + k * 1024); } while (0)
#define PG8_LDB(dst, b, h) do { _Pragma("unroll") for (int n = 0; n < 2; ++n) _Pragma("unroll") for (int k = 0; k < 2; ++k) dst[n][k] = *(const PG8_LAS bf16x8*)(lds + PG8_SB(b, h) + boff + n * 2048 + k * 1024); } while (0)
#define PG8_MMA(ai, bj, At, Bt) do { __builtin_amdgcn_s_setprio(1); _Pragma("unroll") for (int m = 0; m < 4; ++m) _Pragma("unroll") for (int n = 0; n < 2; ++n) _Pragma("unroll") for (int k = 0; k < 2; ++k) \
        acc[ai][bj][m][n] = __builtin_amdgcn_mfma_f32_16x16x32_bf16(Bt[n][k], At[m][k], acc[ai][bj][m][n], 0, 0, 0); __builtin_amdgcn_s_setprio(0); } while (0)
#define PG8_WAIT_V(n) asm volatile("s_waitcnt vmcnt(" #n ")" ::: "memory")
#define PG8_WAIT_L(n) asm volatile("s_waitcnt lgkmcnt(" #n ")" ::: "memory")
#define PG8_BAR __builtin_amdgcn_s_barrier()
#define PG8_SCHED __builtin_amdgcn_sched_barrier(0)
    Unit cur, nxt; int ui = 0;
    if (!S.next(0, cur)) return;
    f32x4 acc[2][2][4][2];
#pragma unroll
    for (int a = 0; a < 2; ++a)
#pragma unroll
        for (int b = 0; b < 2; ++b)
#pragma unroll
            for (int m = 0; m < 4; ++m)
#pragma unroll
                for (int n = 0; n < 2; ++n) acc[a][b][m][n] = (f32x4){0.f, 0.f, 0.f, 0.f};
    bf16x8 At[4][2], B0[2][2], B1[2][2];
    const char* cA = (const char*)g.A + (size_t)cur.pm * tstepA + (size_t)cur.kt0 * kstep; const char* cB = (const char*)g.Bt + (size_t)cur.pn * tstepB + (size_t)cur.kt0 * kstep;
    S.a_ready(cur);
    if constexpr (SP2) {
        PG8_STAGE(PG8_SB(0, 0), cB, voffB); PG8_STAGE(PG8_SB(0, 1), cB + hstepB, voffB); PG8_STAGE(PG8_SA(0, 0), cA, voffA); PG8_STAGE(PG8_SA(0, 1), cA + hstepA, voffA);
        if (wr == 1) PG8_BAR;
        PG8_WAIT_V(2); PG8_BAR;
        PG8_STAGE(PG8_SB(1, 0), cB + kstep, voffB); PG8_STAGE(PG8_SA(1, 0), cA + kstep, voffA); PG8_STAGE(PG8_SB(1, 1), cB + hstepB + kstep, voffB);
        PG8_WAIT_V(6); PG8_BAR;
    } else {
        PG8_STAGE(PG8_SB(0, 0), cB, voffB); PG8_STAGE(PG8_SA(0, 0), cA, voffA); PG8_STAGE(PG8_SB(0, 1), cB + hstepB, voffB); PG8_STAGE(PG8_SA(0, 1), cA + hstepA, voffA);
        if (wr == 1) PG8_BAR;
        PG8_WAIT_V(4); PG8_BAR;
        PG8_STAGE(PG8_SB(1, 0), cB + kstep, voffB); PG8_STAGE(PG8_SA(1, 0), cA + kstep, voffA); PG8_STAGE(PG8_SB(1, 1), cB + hstepB + kstep, voffB);
        PG8_WAIT_V(6); PG8_BAR;
    }
    for (;;) {
        const bool has_next = S.next(ui + 1, nxt);
        const char* nA = has_next ? (const char*)g.A + (size_t)nxt.pm * tstepA + (size_t)nxt.kt0 * kstep : cA; const char* nB = has_next ? (const char*)g.Bt + (size_t)nxt.pn * tstepB + (size_t)nxt.kt0 * kstep : cB;
        const int nt = cur.nt;
        for (int t = 0; t < nt; t += 2) {
            const bool last = (t == nt - 2);
            const char* a1 = cA + (size_t)(t + 1) * kstep;
            const char* a2 = last ? nA : cA + (size_t)(t + 2) * kstep; const char* b2 = last ? nB : cB + (size_t)(t + 2) * kstep;
            const char* a3 = a2 + kstep; const char* b3 = b2 + kstep;
            if constexpr (Epi::HORNER) { if (t + cur.kt0 == 32 || t + cur.kt0 == 48) E.mid(acc, cur, t + cur.kt0, wr, wc, fr, fq); }
            if (last && has_next) S.a_ready(nxt);
            if constexpr (SP2) {
            PG8_LDB(B0, 0, 0); PG8_LDB(B1, 0, 1); PG8_SCHED; PG8_LDA(At, 0, 0); PG8_STAGE(PG8_SA(1, 1), a1 + hstepA, voffA);
            PG8_WAIT_V(8); PG8_WAIT_L(0); PG8_BAR; PG8_MMA(0, 0, At, B0); PG8_MMA(0, 1, At, B1); PG8_BAR; PG8_SCHED;
            PG8_LDA(At, 0, 1); PG8_STAGE(PG8_SB(0, 0), b2, voffB); PG8_STAGE(PG8_SB(0, 1), b2 + hstepB, voffB); PG8_STAGE(PG8_SA(0, 0), a2, voffA);
            PG8_WAIT_V(8); PG8_WAIT_L(0); PG8_BAR; PG8_MMA(1, 0, At, B0); PG8_MMA(1, 1, At, B1); PG8_BAR; PG8_SCHED;
            PG8_LDB(B0, 1, 0); PG8_LDB(B1, 1, 1); PG8_SCHED; PG8_LDA(At, 1, 0); PG8_STAGE(PG8_SA(0, 1), a2 + hstepA, voffA);
            PG8_WAIT_V(8); PG8_WAIT_L(0); PG8_BAR; PG8_MMA(0, 0, At, B0); PG8_MMA(0, 1, At, B1); PG8_BAR; PG8_SCHED;
            PG8_LDA(At, 1, 1); PG8_STAGE(PG8_SB(1, 0), b3, voffB); PG8_STAGE(PG8_SB(1, 1), b3 + hstepB, voffB); PG8_STAGE(PG8_SA(1, 0), a3, voffA);
            PG8_WAIT_V(8); PG8_WAIT_L(0); PG8_BAR; PG8_MMA(1, 0, At, B0); PG8_MMA(1, 1, At, B1); PG8_BAR; PG8_SCHED;
            } else {
            PG8_LDB(B0, 0, 0); PG8_SCHED; PG8_LDA(At, 0, 0); PG8_STAGE(PG8_SA(1, 1), a1 + hstepA, voffA);
            PG8_WAIT_L(8); PG8_BAR; PG8_WAIT_L(0); PG8_MMA(0, 0, At, B0); PG8_BAR; PG8_SCHED;
            PG8_LDB(B1, 0, 1); PG8_STAGE(PG8_SB(0, 0), b2, voffB);
            PG8_BAR; PG8_WAIT_L(0); PG8_MMA(0, 1, At, B1); PG8_BAR;
            PG8_LDA(At, 0, 1); PG8_STAGE(PG8_SA(0, 0), a2, voffA);
            PG8_BAR; PG8_WAIT_L(0); PG8_MMA(1, 0, At, B0); PG8_BAR; PG8_SCHED;
            PG8_STAGE(PG8_SB(0, 1), b2 + hstepB, voffB);
            PG8_WAIT_V(6); PG8_BAR; PG8_MMA(1, 1, At, B1); PG8_BAR;
            PG8_LDB(B0, 1, 0); PG8_SCHED; PG8_LDA(At, 1, 0); PG8_STAGE(PG8_SA(0, 1), a2 + hstepA, voffA);
            PG8_WAIT_L(8); PG8_BAR; PG8_WAIT_L(0); PG8_MMA(0, 0, At, B0); PG8_BAR; PG8_SCHED;
            PG8_LDB(B1, 1, 1); PG8_STAGE(PG8_SB(1, 0), b3, voffB);
            PG8_BAR; PG8_WAIT_L(0); PG8_MMA(0, 1, At, B1); PG8_BAR;
            PG8_LDA(At, 1, 1); PG8_STAGE(PG8_SA(1, 0), a3, voffA);
            PG8_BAR; PG8_WAIT_L(0); PG8_MMA(1, 0, At, B0); PG8_BAR; PG8_SCHED;
            PG8_STAGE(PG8_SB(1, 1), b3 + hstepB, voffB);
            PG8_WAIT_V(6); PG8_BAR; PG8_MMA(1, 1, At, B1); PG8_BAR;
            }
        }
        if constexpr (ALIGN_EPI) { if (wr == 0) PG8_BAR; }
        E(acc, cur, wr, wc, fr, fq); S.done(cur);
        if (!has_next) break;
#pragma unroll
        for (int a = 0; a < 2; ++a)
#pragma unroll
            for (int b = 0; b < 2; ++b)
#pragma unroll
                for (int m = 0; m < 4; ++m)
#pragma unroll
                    for (int n = 0; n < 2; ++n) acc[a][b][m][n] = (f32x4){0.f, 0.f, 0.f, 0.f};
        cur = nxt; cA = nA; cB = nB; ++ui;
        if constexpr (ALIGN_EPI) { if (wr == 1) PG8_BAR; }
    }
    PG8_WAIT_V(0);
    if constexpr (!ALIGN_EPI) { if (wr == 0) PG8_BAR; }
    PG8_BAR;
#undef PG8_SA
#undef PG8_SB
#undef PG8_STAGE
#undef PG8_LDA
#undef PG8_LDB
#undef PG8_MMA
#undef PG8_WAIT_V
#undef PG8_WAIT_L
#undef PG8_BAR
#undef PG8_SCHED
}
}

constexpr int D = 4096, NB = 4, SEQ = 4096, DEPTH = 4, GRIDW = 64, CTXL = 256, HD = 128;
constexpr int TPB = CTXL + SEQ;
constexpr int M = NB * TPB;
constexpr int INW = 9728, DFF = 11008, GRK = 512, ADAR = 256;
constexpr int C_AQ = 0, C_AK = 2048, C_AV = 2560, C_BQ = 3072, C_BK = 4096, C_BV = 5120, C_CQ = 6144, C_CK = 7168, C_CV = 8192, C_GL = 9216;
constexpr float EPS = 1e-6f;

constexpr size_t MiB = 1u << 20;
constexpr size_t WS_CTL = 0, CTL_ZERO_BYTES = 1 * MiB;
constexpr size_t WS_T1P = 1 * MiB;
constexpr size_t WS_MOD = 2 * MiB;
constexpr size_t WS_ROPE = 4 * MiB;
constexpr size_t WS_LAM = 4 * MiB + 65536;
constexpr size_t WS_BMASK = 5 * MiB;
constexpr size_t WS_BIAS = 6 * MiB;
constexpr size_t WS_W = 16 * MiB;
constexpr size_t W_IN = 0, W_GATE = W_IN + (size_t)INW * D * 2, W_BR = W_GATE + (size_t)3 * D * GRK * 2, W_OUT = W_BR + (size_t)D * D * 2,
                 W_FFI = W_OUT + (size_t)D * D * 2, W_FFO = W_FFI + (size_t)2 * DFF * D * 2, W_LAYER = W_FFO + (size_t)D * DFF * 2;
constexpr size_t WS_X = 1664 * MiB;
constexpr size_t WS_H = 1936 * MiB;
constexpr size_t WS_PROJ = 2072 * MiB;
constexpr size_t WS_MIX = 2395 * MiB;
constexpr size_t WS_G = 2531 * MiB;
constexpr size_t WS_MRG = 2939 * MiB;
constexpr size_t WS_Y = 3075 * MiB;
constexpr size_t WS_ACT = 3347 * MiB;
constexpr size_t WS_YP = 3713 * MiB;
constexpr size_t WS_END = 3777 * MiB;
static_assert(WS_W + DEPTH * W_LAYER <= WS_X && WS_X + (size_t)M * D * 4 <= WS_H && WS_H + (size_t)M * D * 2 <= WS_PROJ && WS_PROJ + (size_t)M * INW * 2 <= WS_MIX &&
              WS_MIX + (size_t)M * D * 2 <= WS_G && WS_G + (size_t)M * 3 * D * 2 <= WS_MRG && WS_MRG + (size_t)M * D * 2 <= WS_Y && WS_Y + (size_t)M * D * 4 <= WS_ACT &&
              WS_ACT + (size_t)M * DFF * 2 <= WS_YP && WS_YP + (size_t)4 * 1024 * D * 4 <= WS_END && WS_BIAS + (size_t)4 * 8 * 15 * 2 * 2048 * 4 <= WS_W, "d_ws map");
constexpr int CW_BAR = 4096;

constexpr int RING_BYTES = 139264;
constexpr int MISC_OFF = RING_BYTES;
constexpr int LDS_BYTES = 147456;
static_assert(MISC_OFF + 256 <= LDS_BYTES, "LDS map");

#define GAS __attribute__((address_space(1)))
#define LAS __attribute__((address_space(3)))
typedef unsigned short bf16;
typedef unsigned v4u __attribute__((ext_vector_type(4)));
typedef unsigned v2u __attribute__((ext_vector_type(2)));
typedef float f32x4 __attribute__((ext_vector_type(4)));
typedef short bf16x8 __attribute__((ext_vector_type(8)));
typedef short s16x4 __attribute__((ext_vector_type(4)));
typedef float f32x16 __attribute__((ext_vector_type(16)));
#define RLX_AGENT __ATOMIC_RELAXED, __HIP_MEMORY_SCOPE_AGENT
__device__ __forceinline__ unsigned f2bf(float f) { unsigned u = __builtin_bit_cast(unsigned, f); return (u + 0x7fffu + ((u >> 16) & 1u)) >> 16; }
__device__ __forceinline__ unsigned pk2(float lo, float hi) { return pg8::cvt_pk_bf16(lo, hi); }
__device__ __forceinline__ float bflo(unsigned w) { return __uint_as_float(w << 16); }
__device__ __forceinline__ float bfhi(unsigned w) { return __uint_as_float(w & 0xffff0000u); }
__device__ __forceinline__ float wave_sum(float v) {
#pragma unroll
    for (int o = 1; o < 64; o <<= 1) v += __shfl_xor(v, o);
    return v;
}

#define XB_TMO      128
#define XB_XCNT(j)  (256  + 64 * (j))
#define XB_XSUB(j)  (1280 + 64 * (j))
#define XB_XGEN(j)  (2304 + 64 * (j))
#define XB_TOP      3328
#define XB_TOPGEN   3392
#define XCD_BAR_WORDS 3456
#define XB_SPIN_CAP (1u << 22)
__device__ __forceinline__ unsigned xb_ld(unsigned* p)              { return __hip_atomic_load(p, __ATOMIC_RELAXED, __HIP_MEMORY_SCOPE_AGENT); }
__device__ __forceinline__ unsigned xb_add(unsigned* p, unsigned v) { return __hip_atomic_fetch_add(p, v, __ATOMIC_RELAXED, __HIP_MEMORY_SCOPE_AGENT); }
__device__ __forceinline__ unsigned xb_xcc_id() { return (unsigned)__builtin_amdgcn_s_getreg((3 << 11) | 20) & 0xFu; }
#define XB_SPIN(cond, bar) do { unsigned _sp = 0; while (cond) { __builtin_amdgcn_s_sleep(1); \
    if ((++_sp & 255u) == 0u) { if (xb_ld(&(bar)[XB_TMO])) break; if (_sp > XB_SPIN_CAP) { atomicAdd(&(bar)[XB_TMO], 1u); break; } } } } while (0)
struct XcdBarrier { unsigned* bar; unsigned x; volatile LAS unsigned* st; };
__device__ __forceinline__ XcdBarrier xcd_barrier_post(unsigned* bar, volatile LAS unsigned* st) {
    XcdBarrier b; b.bar = bar; b.x = xb_xcc_id(); b.st = st;
    if (threadIdx.x == 0) (void)xb_add(&bar[XB_XCNT(b.x)], 1u);
    return b;
}
__device__ __forceinline__ void xcd_barrier_complete(unsigned* bar, unsigned x, unsigned& nloc, unsigned& nx) {
    const unsigned G = gridDim.x * gridDim.y * gridDim.z;
    unsigned sum, cnt, mine, sp = 0u;
    for (;;) {
        sum = 0u; cnt = 0u; mine = 0u;
#pragma unroll
        for (unsigned j = 0; j < 16; ++j) { const unsigned c = xb_ld(&bar[XB_XCNT(j)]); sum += c; cnt += (c > 0u) ? 1u : 0u; mine = (j == x) ? c : mine; }
        if (sum == G) break;
        __builtin_amdgcn_s_sleep(1);
        if ((++sp & 255u) == 0u) { if (xb_ld(&bar[XB_TMO])) break; if (sp > XB_SPIN_CAP) { atomicAdd(&bar[XB_TMO], 1u); break; } }
    }
    nloc = mine > 0u ? mine : 1u; nx = cnt > 0u ? cnt : 1u;
}
__device__ __forceinline__ void xcd_barrier(const XcdBarrier& b) {
    asm volatile("s_waitcnt vmcnt(0)" ::: "memory");
    __syncthreads();
    if (threadIdx.x == 0) {
        unsigned* bar = b.bar;
        __builtin_amdgcn_s_waitcnt(0);
        unsigned nloc = b.st[0], nx = b.st[1];
        if (nloc == 0u) { xcd_barrier_complete(bar, b.x, nloc, nx); b.st[0] = nloc; b.st[1] = nx; }
        const unsigned old = xb_add(&bar[XB_XSUB(b.x)], 1u);
        const unsigned gen = old / nloc;
        if (old + 1u == (gen + 1u) * nloc) {
            __builtin_amdgcn_fence(__ATOMIC_RELEASE, "agent");
            asm volatile("s_waitcnt vmcnt(0)" ::: "memory");
            const unsigned og = xb_add(&bar[XB_TOP], 1u);
            const unsigned tg = og / nx;
            if (og + 1u == (tg + 1u) * nx) xb_add(&bar[XB_TOPGEN], 1u);
            else XB_SPIN(xb_ld(&bar[XB_TOPGEN]) == tg, bar);
            __builtin_amdgcn_fence(__ATOMIC_ACQUIRE, "agent");
            xb_add(&bar[XB_XGEN(b.x)], 1u);
            asm volatile("s_waitcnt vmcnt(0)" ::: "memory");
        } else {
            XB_SPIN(xb_ld(&bar[XB_XGEN(b.x)]) == gen, bar);
            __builtin_amdgcn_fence(__ATOMIC_ACQUIRE, "agent");
            asm volatile("s_waitcnt vmcnt(0)" ::: "memory");
        }
    }
    __syncthreads();
}

namespace att {
constexpr int KVBLK = 64, LDQ = INW, LDK = INW;
constexpr int SHM_V = KVBLK * 128 * 2, SHM_K = KVBLK * 128 * 2, WS_OFF = 2 * SHM_V + 2 * SHM_K, OST_OFF = WS_OFF + 8 * 64 * 4, OST_STRIDE = 272, OST_WAVE = 32 * OST_STRIDE, LDS_NEED = OST_OFF + 8 * OST_WAVE;
static_assert(LDS_NEED <= RING_BYTES, "attention LDS");
#define KSWZ(row, colB) ((row) * 256 + ((colB) ^ (((row) & 7) << 4)))
#define SBAR() __builtin_amdgcn_sched_barrier(0)
__device__ __forceinline__ int crow(int r, int hi) { return (r & 3) + 8 * (r >> 2) + 4 * hi; }
__device__ __forceinline__ unsigned cvtpk(float lo, float hi) { unsigned r; asm volatile("v_cvt_pk_bf16_f32 %0, %1, %2" : "=v"(r) : "v"(lo), "v"(hi)); return r; }
constexpr float THR = 8.f;
template <int MODE> struct Cfg { static constexpr float SCALE = (MODE == 1) ? 0.125f : 0.088388347648318440f; static constexpr int ND0 = (MODE == 1) ? 4 : 8; };

template <int MODE> __device__ __forceinline__ void partialSM(f32x16& p0, f32x16& p1, float& m_reg, float& mn, float& alpha) {
  constexpr float SC = Cfg<MODE>::SCALE, C = SC * 1.4426950408889634f;
  float pmax = p0[0]; for (int r = 1; r < 16; ++r) pmax = fmaxf(pmax, p0[r]); for (int r = 0; r < 16; ++r) pmax = fmaxf(pmax, p1[r]);
  { auto rr = __builtin_amdgcn_permlane32_swap(__float_as_uint(pmax), __float_as_uint(pmax), false, false);
    pmax = fmaxf(__uint_as_float(rr[0]), __uint_as_float(rr[1])); }
  if (__builtin_expect(__all(pmax - m_reg <= THR / SC), 1)) { mn = m_reg; alpha = 1.f; }
  else { mn = fmaxf(m_reg, pmax); alpha = __builtin_amdgcn_exp2f((m_reg - mn) * C); m_reg = mn; }
  float mnC = -mn * C;
  for (int r = 0; r < 16; ++r) p0[r] = fmaf(p0[r], C, mnC); for (int r = 0; r < 16; ++r) p1[r] = fmaf(p1[r], C, mnC);
  for (int r = 0; r < 16; ++r) p0[r] = __builtin_amdgcn_exp2f(p0[r]);
}
__device__ __forceinline__ void finishSM(f32x16& p0, f32x16& p1, float alpha, float& l_reg, bf16x8& pa0, bf16x8& pa1, bf16x8& pa2, bf16x8& pa3) {
  for (int r = 0; r < 16; ++r) p1[r] = __builtin_amdgcn_exp2f(p1[r]);
  float ps = 0; for (int r = 0; r < 16; ++r) ps += p0[r]; for (int r = 0; r < 16; ++r) ps += p1[r];
  { auto rr = __builtin_amdgcn_permlane32_swap(__float_as_uint(ps), __float_as_uint(ps), false, false);
    ps = __uint_as_float(rr[0]) + __uint_as_float(rr[1]); }
  l_reg = l_reg * alpha + ps;
#define PK4(P, BASE, OUT) do { unsigned a0 = cvtpk(P[BASE + 0], P[BASE + 1]), a1 = cvtpk(P[BASE + 2], P[BASE + 3]);   \
    unsigned b0 = cvtpk(P[BASE + 4], P[BASE + 5]), b1 = cvtpk(P[BASE + 6], P[BASE + 7]);                              \
    auto r0 = __builtin_amdgcn_permlane32_swap(a0, b0, false, false); auto r1 = __builtin_amdgcn_permlane32_swap(a1, b1, false, false); \
    v4u w = {r0[0], r1[0], r0[1], r1[1]}; OUT = *reinterpret_cast<bf16x8*>(&w); } while (0)
  PK4(p0, 0, pa0); PK4(p0, 8, pa1); PK4(p1, 0, pa2); PK4(p1, 8, pa3);
#undef PK4
}
template <int MODE> __device__ __forceinline__ void qkt(f32x16& p0, f32x16& p1, const char* Ks, const bf16x8* qr, int r32, int hi, const float* bias, int lane) {
  if constexpr (MODE == 2) {
    const f32x4* bp = (const f32x4*)bias + lane;
#pragma unroll
    for (int g = 0; g < 4; ++g) { const f32x4 a = bp[g * 64], b = bp[(4 + g) * 64];
#pragma unroll
      for (int j = 0; j < 4; ++j) { p0[4 * g + j] = a[j]; p1[4 * g + j] = b[j]; } }
  } else { p0 = f32x16{}; p1 = f32x16{}; }
#pragma unroll
  for (int d0 = 0; d0 < Cfg<MODE>::ND0; ++d0) { int cb = (d0 * 16 + hi * 8) * 2;
    bf16x8 b0 = *reinterpret_cast<const bf16x8*>(Ks + KSWZ(r32, cb));
    bf16x8 b1 = *reinterpret_cast<const bf16x8*>(Ks + KSWZ(32 + r32, cb));
    p0 = __builtin_amdgcn_mfma_f32_32x32x16_bf16(b0, qr[d0], p0, 0, 0, 0);
    p1 = __builtin_amdgcn_mfma_f32_32x32x16_bf16(b1, qr[d0], p1, 0, 0, 0); }
}
__device__ __forceinline__ int v_st(int k, int c) { const int kk = (k & ~0xC) | ((k & 4) << 1) | ((k & 8) >> 1); return ((kk >> 3) * 4 + (c >> 5)) * 512 + ((kk & 7) * 32 + (c & 31)) * 2; }
__device__ __forceinline__ int v_rd_base(int lane) { return ((lane & 3) << 3) | (((lane >> 2) & 3) << 6) | (((lane >> 4) & 1) << 5) | (((lane >> 5) & 1) << 8); }
constexpr int v_rd_off(int d0, int ks, int half) { return d0 * 512 + ks * 4096 + half * 2048; }
template <int OFF> __device__ __forceinline__ s16x4 tr_read(int vb) {
  s16x4 r; asm volatile("ds_read_b64_tr_b16 %0, %1 offset:%2" : "=&v"(r) : "v"(vb), "i"(OFF) : "memory"); return r;
}
template <int D0> __device__ __forceinline__ void pv_one(f32x16& od, int vb, bf16x8 pa0, bf16x8 pa1, bf16x8 pa2, bf16x8 pa3) {
  const s16x4 l0 = tr_read<v_rd_off(D0, 0, 0)>(vb), h0 = tr_read<v_rd_off(D0, 0, 1)>(vb), l1 = tr_read<v_rd_off(D0, 1, 0)>(vb), h1 = tr_read<v_rd_off(D0, 1, 1)>(vb);
  const s16x4 l2 = tr_read<v_rd_off(D0, 2, 0)>(vb), h2 = tr_read<v_rd_off(D0, 2, 1)>(vb), l3 = tr_read<v_rd_off(D0, 3, 0)>(vb), h3 = tr_read<v_rd_off(D0, 3, 1)>(vb);
  asm volatile("s_waitcnt lgkmcnt(0)" ::: "memory"); SBAR();
#define PK(L, H) (bf16x8){L[0], L[1], L[2], L[3], H[0], H[1], H[2], H[3]}
  od = __builtin_amdgcn_mfma_f32_32x32x16_bf16(pa0, PK(l0, h0), od, 0, 0, 0);
  od = __builtin_amdgcn_mfma_f32_32x32x16_bf16(pa1, PK(l1, h1), od, 0, 0, 0);
  od = __builtin_amdgcn_mfma_f32_32x32x16_bf16(pa2, PK(l2, h2), od, 0, 0, 0);
  od = __builtin_amdgcn_mfma_f32_32x32x16_bf16(pa3, PK(l3, h3), od, 0, 0, 0);
#undef PK
}
__device__ __forceinline__ void pv_d0(f32x16* o, int vb, bf16x8 pa0, bf16x8 pa1, bf16x8 pa2, bf16x8 pa3) {
  pv_one<0>(o[0], vb, pa0, pa1, pa2, pa3); pv_one<1>(o[1], vb, pa0, pa1, pa2, pa3); pv_one<2>(o[2], vb, pa0, pa1, pa2, pa3); pv_one<3>(o[3], vb, pa0, pa1, pa2, pa3);
}

struct Tiles {
  int NT;
  int jmax;
  int jsplit, extra;
  const float* btab;
  const float* bmask; const float* bzero;
  int rlo, nrows, Rw, r0w, half;
  __device__ __forceinline__ int krow(int j) const { const int je = j < jmax ? j : jmax; return je * 64 + (je >= jsplit ? extra : 0); }
  __device__ __forceinline__ const float* bias(int j) const {
    if (j < 4) return bzero;
    const int i = j - 4, rr = rlo + i; const bool in = (i < nrows) && (rr >= r0w) && (rr < r0w + 8);
    return in ? btab + (size_t)((rr - Rw + 7) * 2 + half) * 2048 : bmask;
  }
};

template <int MODE>
__device__ __forceinline__ void attn_core(const bf16* Pb, unsigned qoff, unsigned koff, unsigned voff, const Tiles& T, int kcolB, char* lds, f32x16 (&o)[4]) {
  const int tid = opaque_tid(), wid = __builtin_amdgcn_readfirstlane(tid >> 6), lane = tid & 63, r32 = lane & 31, hi = lane >> 5;
  char* V_lds = lds; char* K_lds = lds + 2 * SHM_V;
  float* ws = (float*)(lds + WS_OFF) + wid * 64; float* li_l = ws; float* al_l = ws + 32;
  float m_reg = -1e30f, l_reg = 0; bf16x8 qr[Cfg<MODE>::ND0];
#pragma unroll
  for (int d = 0; d < 4; ++d) o[d] = f32x16{};
  const __amdgpu_buffer_rsrc_t rsrc = __builtin_amdgcn_make_buffer_rsrc((void*)Pb, 0, (int)((size_t)M * INW * 2), 0x00020000);
  { const unsigned qv = (unsigned)((wid * 32 + r32) * LDQ + hi * 8) * 2u, qs = __builtin_amdgcn_readfirstlane(qoff * 2u);
#pragma unroll
    for (int d0 = 0; d0 < Cfg<MODE>::ND0; ++d0) { const v4u w = __builtin_amdgcn_raw_buffer_load_b128(rsrc, qv + d0 * 32, qs, 0); qr[d0] = *reinterpret_cast<const bf16x8*>(&w); } }
  const int sr = tid >> 4, sc = (tid & 15) * 8, vst0 = v_st(sr, sc), vst1 = v_st(32 + sr, sc);
  const unsigned kvv = (unsigned)(sr * LDK + sc) * 2u;
  const int vb0 = (int)(uintptr_t)V_lds + v_rd_base(lane);
  struct { bf16x8 vs0, vs1, ks0, ks1; } sr_[2];
#define SLOAD(i, j) do { const unsigned k0_ = (unsigned)T.krow(j) * (unsigned)(LDK * 2), vs_ = __builtin_amdgcn_readfirstlane(voff * 2u + k0_), ks_ = __builtin_amdgcn_readfirstlane(koff * 2u + k0_); \
    v4u t0_ = __builtin_amdgcn_raw_buffer_load_b128(rsrc, kvv, vs_, 0), t1_ = __builtin_amdgcn_raw_buffer_load_b128(rsrc, kvv, vs_ + 32u * LDK * 2u, 0); \
    v4u t2_ = __builtin_amdgcn_raw_buffer_load_b128(rsrc, kvv, ks_, 0), t3_ = __builtin_amdgcn_raw_buffer_load_b128(rsrc, kvv, ks_ + 32u * LDK * 2u, 0); \
    sr_[i].vs0 = *reinterpret_cast<bf16x8*>(&t0_); sr_[i].vs1 = *reinterpret_cast<bf16x8*>(&t1_); sr_[i].ks0 = *reinterpret_cast<bf16x8*>(&t2_); sr_[i].ks1 = *reinterpret_cast<bf16x8*>(&t3_); } while (0)
#define SWRITE(b, i) do { *(bf16x8*)(V_lds + (b) * SHM_V + vst0) = sr_[i].vs0;          \
    *(bf16x8*)(V_lds + (b) * SHM_V + vst1) = sr_[i].vs1; int kc = sc * 2;               \
    *(bf16x8*)(K_lds + (b) * SHM_K + KSWZ(sr, kc)) = sr_[i].ks0;                       \
    *(bf16x8*)(K_lds + (b) * SHM_K + KSWZ(32 + sr, kc)) = sr_[i].ks1; } while (0)
#define SWAIT() asm volatile("s_waitcnt vmcnt(4)" ::: "memory")
#define RESC(a) do { if (__any((a) < 1.f)) { if (hi == 0) al_l[r32] = (a); asm volatile("s_waitcnt lgkmcnt(0)" ::: "memory"); \
    for (int d = 0; d < 4; ++d) for (int r = 0; r < 16; ++r) o[d][r] *= al_l[crow(r, hi)]; } } while (0)
  f32x16 pA0, pA1, pB0, pB1; float mnA, mnB, alA, alB; bf16x8 pa0, pa1, pa2, pa3; const int NT = T.NT;
  const char* K0 = K_lds + kcolB; const char* K1 = K_lds + SHM_K + kcolB;
  constexpr int SE = 0, SO = 1;
  SLOAD(SE, 0); asm volatile("s_waitcnt vmcnt(0)" ::: "memory"); SWRITE(0, SE); __syncthreads();
  qkt<MODE>(pA0, pA1, K0, qr, r32, hi, MODE == 2 ? T.bias(0) : nullptr, lane); partialSM<MODE>(pA0, pA1, m_reg, mnA, alA);
  SLOAD(SO, 1); if (2 < NT) SLOAD(SE, 2);
  SWAIT(); SWRITE(1, SO); __syncthreads();
  for (int j = 1; j + 1 < NT; j += 2) {
    SBAR(); qkt<MODE>(pB0, pB1, K1, qr, r32, hi, MODE == 2 ? T.bias(j) : nullptr, lane);
    finishSM(pA0, pA1, alA, l_reg, pa0, pa1, pa2, pa3); SBAR();
    SLOAD(SO, j + 2); SBAR();
    pv_d0(o, vb0, pa0, pa1, pa2, pa3); partialSM<MODE>(pB0, pB1, m_reg, mnB, alB);
    __syncthreads(); SWAIT(); SWRITE(0, SE);
    RESC(alB); __syncthreads();
    SBAR(); qkt<MODE>(pA0, pA1, K0, qr, r32, hi, MODE == 2 ? T.bias(j + 1) : nullptr, lane);
    finishSM(pB0, pB1, alB, l_reg, pa0, pa1, pa2, pa3); SBAR();
    if (j + 3 < NT) SLOAD(SE, j + 3); SBAR();
    pv_d0(o, vb0 + (int)SHM_V, pa0, pa1, pa2, pa3); partialSM<MODE>(pA0, pA1, m_reg, mnA, alA);
    __syncthreads(); SWAIT(); SWRITE(1, SO);
    RESC(alA); __syncthreads();
  }
  SBAR(); qkt<MODE>(pB0, pB1, K1, qr, r32, hi, MODE == 2 ? T.bias(NT - 1) : nullptr, lane);
  finishSM(pA0, pA1, alA, l_reg, pa0, pa1, pa2, pa3); SBAR();
  pv_d0(o, vb0, pa0, pa1, pa2, pa3); partialSM<MODE>(pB0, pB1, m_reg, mnB, alB);
  __syncthreads(); RESC(alB);
  finishSM(pB0, pB1, alB, l_reg, pa0, pa1, pa2, pa3); SBAR();
  pv_d0(o, vb0 + (int)SHM_V, pa0, pa1, pa2, pa3);
  if (hi == 0) li_l[r32] = l_reg; asm volatile("s_waitcnt lgkmcnt(0)" ::: "memory");
#pragma unroll
  for (int r = 0; r < 16; ++r) { const float rl = __builtin_amdgcn_rcpf(li_l[crow(r, hi)]);
#pragma unroll
    for (int d0 = 0; d0 < 4; ++d0) o[d0][r] *= rl; }
  __syncthreads();
#undef SLOAD
#undef SWRITE
#undef SWAIT
#undef RESC
}
__device__ __forceinline__ void store_o_bf16(const f32x16 (&o)[4], bf16* Ob, char* lds) {
  const int tid = opaque_tid(), wid = __builtin_amdgcn_readfirstlane(tid >> 6), lane = tid & 63, r32 = lane & 31, hi = lane >> 5;
  char* st = lds + OST_OFF + wid * OST_WAVE;
#pragma unroll
  for (int r = 0; r < 16; ++r) { const int row = crow(r, hi);
#pragma unroll
    for (int d0 = 0; d0 < 4; ++d0) *(unsigned short*)(st + row * OST_STRIDE + (d0 * 32 + r32) * 2) = (unsigned short)f2bf(o[d0][r]); }
  asm volatile("s_waitcnt lgkmcnt(0)" ::: "memory");
#pragma unroll
  for (int i = 0; i < 8; ++i) { const int row = i * 4 + (lane >> 4), ch = lane & 15;
    const v4u w = *(const v4u*)(st + row * OST_STRIDE + ch * 16);
    *(v4u*)(Ob + (size_t)(wid * 32 + row) * D + ch * 8) = w; }
  asm volatile("s_waitcnt lgkmcnt(0)" ::: "memory");
}
#undef KSWZ
}

struct Args { const float* in[26]; float* out; unsigned char* ws; int ph_lo, ph_hi, li, pad; };
enum { I_X = 0, I_C, I_CTX, I_CCTX, I_ADOWN, I_AUP, I_ABIAS, I_NMPRE, I_NMPOST, I_NFPRE, I_NFPOST, I_WIN, I_AQN, I_AKN, I_RPB, I_LQ1, I_LK1, I_LQ2, I_LK2, I_SUBLN, I_WGU, I_BGATE, I_WBR, I_WOUT, I_WFFI, I_WFFO };

__device__ __forceinline__ const float* inp(int i) { asm volatile("" : "+s"(i)); return ((const float* const*)__builtin_amdgcn_kernarg_segment_ptr())[i]; }
__device__ __forceinline__ float* outp() { int i = 26; asm volatile("" : "+s"(i)); return ((float* const*)__builtin_amdgcn_kernarg_segment_ptr())[i]; }
struct Frame {
    LAS unsigned char* lds; unsigned char* ws; int vcu, G;
};

__device__ __forceinline__ void transpose_item(const float* W, int K, int N, bf16* Bt, int k0, int n0, int r0, LAS float* scr, int lane) {
    const float* src = W + (size_t)k0 * N + n0 + (lane & 15) * 4;
#pragma unroll 4
    for (int i = 0; i < 16; ++i) { const int kk = 4 * i + (lane >> 4); const f32x4 v = *(const f32x4*)(src + (size_t)kk * N);
        LAS float* d = scr + kk * 65 + (lane & 15) * 4; d[0] = v[0]; d[1] = v[1]; d[2] = v[2]; d[3] = v[3]; }
    asm volatile("s_waitcnt lgkmcnt(0)" ::: "memory");
    const int c = lane & 7;
#pragma unroll
    for (int j = 0; j < 8; ++j) { const int n = (lane >> 3) + 8 * j; const LAS float* s = scr + (8 * c) * 65 + n;
        v4u o; o.x = pk2(s[0 * 65], s[1 * 65]); o.y = pk2(s[2 * 65], s[3 * 65]); o.z = pk2(s[4 * 65], s[5 * 65]); o.w = pk2(s[6 * 65], s[7 * 65]);
        *(v4u*)(Bt + (size_t)(r0 + n) * K + k0 + 8 * c) = o; }
    asm volatile("s_waitcnt lgkmcnt(0)" ::: "memory");
}
__device__ __forceinline__ void phase_p0(const Frame& F, const Args& A) {
    const int tid_ = opaque_tid(), lane_ = tid_ & 63, wave_ = __builtin_amdgcn_readfirstlane(tid_ >> 6); (void)tid_; (void)lane_; (void)wave_;
    const int gw = F.vcu * 8 + wave_, NGW = F.G * 8;
    for (int it = gw; it < 256; it += NGW) {
        const int l = it >> 6, jb = (it >> 4) & 3, kc = it & 15, j = jb * 64 + lane_;
        const float* wd = inp(I_ADOWN) + (size_t)l * D * ADAR; float acc[5] = {0.f, 0.f, 0.f, 0.f, 0.f};
        for (int k = kc * 256; k < kc * 256 + 256; ++k) { const float w = wd[(size_t)k * ADAR + j];
#pragma unroll
            for (int r = 0; r < 5; ++r) { const float cv = (r < 4) ? inp(I_C)[r * D + k] : inp(I_CCTX)[k]; acc[r] += cv * pg8::sigm(cv) * w; } }
        float* t1p = (float*)(F.ws + WS_T1P);
#pragma unroll
        for (int r = 0; r < 5; ++r) t1p[((l * 16 + kc) * 5 + r) * 256 + j] = acc[r];
    }
    LAS float* scr = (LAS float*)(F.lds + wave_ * 16640);
    constexpr int I0 = (D / 64) * (INW / 64), I1 = (GRK / 64) * (3 * D / 64), I2 = (D / 64) * (D / 64), I3 = I2, I4 = (D / 64) * (2 * DFF / 64), I5 = (DFF / 64) * (D / 64), IL = I0 + I1 + I2 + I3 + I4 + I5;
    for (int it = gw; it < DEPTH * IL; it += NGW) {
        const int l = it / IL; int r = it % IL; unsigned char* wb = F.ws + WS_W + (size_t)l * W_LAYER;
        if (r < I0) { const int nb = INW / 64; transpose_item(inp(I_WIN) + (size_t)l * D * INW, D, INW, (bf16*)(wb + W_IN), (r / nb) * 64, (r % nb) * 64, (r % nb) * 64, scr, lane_); continue; } r -= I0;
        if (r < I1) { const int nb = 3 * D / 64; transpose_item(inp(I_WGU) + (size_t)l * GRK * 3 * D, GRK, 3 * D, (bf16*)(wb + W_GATE), (r / nb) * 64, (r % nb) * 64, (r % nb) * 64, scr, lane_); continue; } r -= I1;
        if (r < I2) { const int nb = D / 64; transpose_item(inp(I_WBR) + (size_t)l * D * D, D, D, (bf16*)(wb + W_BR), (r / nb) * 64, (r % nb) * 64, (r % nb) * 64, scr, lane_); continue; } r -= I2;
        if (r < I3) { const int nb = D / 64; transpose_item(inp(I_WOUT) + (size_t)l * D * D, D, D, (bf16*)(wb + W_OUT), (r / nb) * 64, (r % nb) * 64, (r % nb) * 64, scr, lane_); continue; } r -= I3;
        if (r < I4) { const int nb = 2 * DFF / 64; const int n0 = (r % nb) * 64, hf = n0 / DFF, cc = n0 % DFF, r0 = (cc / 128) * 256 + hf * 128 + (cc % 128);
            transpose_item(inp(I_WFFI) + (size_t)l * D * 2 * DFF, D, 2 * DFF, (bf16*)(wb + W_FFI), (r / nb) * 64, n0, r0, scr, lane_); continue; } r -= I4;
        { const int nb = D / 64; transpose_item(inp(I_WFFO) + (size_t)l * DFF * D, DFF, D, (bf16*)(wb + W_FFO), (r / nb) * 64, (r % nb) * 64, (r % nb) * 64, scr, lane_); }
    }
}
__device__ __forceinline__ void phase_p1(const Frame& F, const Args& A) {
    const int tid_ = opaque_tid(), lane_ = tid_ & 63, wave_ = __builtin_amdgcn_readfirstlane(tid_ >> 6); (void)tid_; (void)lane_; (void)wave_;
    const int gw = F.vcu * 8 + wave_, NGW = F.G * 8;
    LAS float* tl = (LAS float*)(F.lds + wave_ * 8192);
    for (int it = gw; it < DEPTH * 96; it += NGW) {
        const int l = it / 96, nb = it % 96, n4 = nb * 256 + lane_ * 4;
        const float* t1p = (const float*)(F.ws + WS_T1P);
#pragma unroll
        for (int q = 0; q < 4; ++q)
#pragma unroll
            for (int r = 0; r < 5; ++r) { const int j = lane_ + 64 * q; float s = 0.f;
                for (int kc = 0; kc < 16; ++kc) s += __hip_atomic_load(t1p + ((l * 16 + kc) * 5 + r) * 256 + j, RLX_AGENT);
                tl[r * 256 + j] = s; }
        asm volatile("s_waitcnt lgkmcnt(0)" ::: "memory");
        const float* wu = inp(I_AUP) + (size_t)l * ADAR * 6 * D + n4;
        f32x4 acc[5];
#pragma unroll
        for (int r = 0; r < 5; ++r) acc[r] = (f32x4){0.f, 0.f, 0.f, 0.f};
#pragma unroll 4
        for (int j = 0; j < ADAR; ++j) { const f32x4 w = *(const f32x4*)(wu + (size_t)j * 6 * D);
#pragma unroll
            for (int r = 0; r < 5; ++r) acc[r] += w * tl[r * 256 + j]; }
        const f32x4 bv = *(const f32x4*)(inp(I_ABIAS) + (size_t)l * 6 * D + n4);
        float* mod = (float*)(F.ws + WS_MOD);
#pragma unroll
        for (int r = 0; r < 5; ++r) *(f32x4*)(mod + ((size_t)l * 5 + r) * 6 * D + n4) = acc[r] + bv;
        asm volatile("s_waitcnt lgkmcnt(0)" ::: "memory");
    }
    const int gt = F.vcu * 512 + tid_, NGT = F.G * 512;
    for (int e = gt; e < 64 * 32 + 64 * 16; e += NGT) {
        float* rp = (float*)(F.ws + WS_ROPE);
        if (e < 2048) { const int pos = e >> 5, i = e & 31; const double a = (double)pos * exp(-9.210340371976184 * (double)i / 32.0); rp[e] = (float)cos(a); rp[2048 + e] = (float)sin(a); }
        else { const int e2 = e - 2048, pos = e2 >> 4, i = e2 & 15; const double a = (double)pos * exp(-9.210340371976184 * (double)i / 16.0); rp[4096 + e2] = (float)cos(a); rp[4096 + 1024 + e2] = (float)sin(a); }
    }
    for (int e = gt; e < 4 * 8 * 15 * 2 * 2048; e += NGT) {
        const int j = e & 3, ln = (e >> 2) & 63, g = (e >> 8) & 7, half = (e >> 11) & 1, rest = e >> 12, dr = rest % 15, lh = rest / 15;
        const int qc = half * 32 + (ln & 31), hi = ln >> 5, kc = ((g < 4) ? 0 : 32) + j + 8 * (g & 3) + 4 * hi;
        int c0 = qc - 8; c0 = c0 < 0 ? 0 : (c0 > 48 ? 48 : c0);
        const bool valid = (kc >= c0) && (kc < c0 + 16);
        int idx = kc - qc + 15; idx = idx < 0 ? 0 : (idx > 30 ? 30 : idx);
        const float v = valid ? inp(I_RPB)[((size_t)lh * 15 + dr) * 31 + idx] * 11.313708498984761f : -1e30f;
        ((float*)(F.ws + WS_BIAS))[e] = v;
    }
    for (int e = gt; e < 4096; e += NGT) ((float*)(F.ws + WS_BMASK))[e] = (e < 2048) ? -1e30f : 0.f;
    if (gw == 0) {
        for (int l = 0; l < DEPTH; ++l) {
            const float a = wave_sum(inp(I_LQ1)[l * 64 + lane_] * inp(I_LK1)[l * 64 + lane_]), b = wave_sum(inp(I_LQ2)[l * 64 + lane_] * inp(I_LK2)[l * 64 + lane_]);
            const float lam_init = 0.8f - 0.6f * expf(-0.3f * (float)l);
            if (lane_ == 0) ((float*)(F.ws + WS_LAM))[l] = expf(a) - expf(b) + lam_init;
        }
    }
}
template <int MODE>
__device__ __forceinline__ void phase_rows(const Frame& F, const Args& A, const float* gpost, const float* modA  , const float* gpre, const float* modSh, const float* modSc, const bool skipctx, const bool tailsum) {
    const int tid_ = opaque_tid(), lane_ = tid_ & 63, wave_ = __builtin_amdgcn_readfirstlane(tid_ >> 6);
    float* X = (float*)(F.ws + WS_X); const bf16* Y = (const bf16*)(F.ws + WS_Y); bf16* H = (bf16*)(F.ws + WS_H);
    LAS float* vA = (LAS float*)F.lds; LAS float* vB = vA + D; LAS float* vS = vB + D;
    const int rpw = (M + F.G - 1) / F.G, m0 = F.vcu * rpw, m1 = (m0 + rpw < M) ? m0 + rpw : M;
    for (int ms = m0; ms < m1;) {
        const int b = ms / TPB, i0 = ms % TPB; const bool isctx = i0 < CTXL; const int segend = b * TPB + (isctx ? CTXL : TPB), me = segend < m1 ? segend : m1;
        if (!(skipctx && isctx)) {
            const size_t mo = (size_t)(isctx ? 4 : b) * 6 * D;
            __syncthreads();
#pragma unroll
            for (int k = 0; k < 2; ++k) { const int c = (tid_ + k * 512) * 4;
                if constexpr (MODE != 0) { const f32x4 gp = *(const f32x4*)(gpost + c), ga = *(const f32x4*)(modA + mo + c); *(LAS f32x4*)(vA + c) = ga * gp; }
                if constexpr (MODE != 2) { const f32x4 g = *(const f32x4*)(gpre + c), sc = *(const f32x4*)(modSc + mo + c), sh = *(const f32x4*)(modSh + mo + c); *(LAS f32x4*)(vB + c) = g * (1.0f + sc); *(LAS f32x4*)(vS + c) = sh; } }
            __syncthreads();
            for (int m = ms + wave_; m < me; m += 8) {
                const int i = m % TPB;
                f32x4 x[16];
                float* xr = X + (size_t)m * D + lane_ * 4;
                if constexpr (MODE == 0) {
                    const float* src = (i < CTXL) ? inp(I_CTX) + ((size_t)b * CTXL + i) * D : inp(I_X) + ((size_t)b * SEQ + (i - CTXL)) * D;
#pragma unroll
                    for (int q = 0; q < 16; ++q) { x[q] = *(const f32x4*)(src + lane_ * 4 + q * 256); *(f32x4*)(xr + q * 256) = x[q]; }
                } else {
                    f32x4 y[16]; float ss = 0.f;
                    if (tailsum && m >= 16384) {
                        const float* yp = (const float*)(F.ws + WS_YP) + (size_t)(m - 16384) * D + lane_ * 4;
#pragma unroll
                        for (int q = 0; q < 16; ++q) y[q] = *(const f32x4*)(yp + q * 256);
#pragma unroll 1
                        for (int p = 1; p < 4; ++p) { const float* ypp = yp + (size_t)p * 1024 * D;
#pragma unroll
                            for (int q = 0; q < 16; ++q) y[q] += *(const f32x4*)(ypp + q * 256); }
                    } else { const bf16* yr = Y + (size_t)m * D + lane_ * 4;
#pragma unroll
                        for (int q = 0; q < 16; ++q) { const v2u w = *(const v2u*)(yr + q * 256); y[q] = (f32x4){bflo(w.x), bfhi(w.x), bflo(w.y), bfhi(w.y)}; } }
#pragma unroll
                    for (int q = 0; q < 16; ++q) { x[q] = *(const f32x4*)(xr + q * 256); ss += (y[q][0] * y[q][0] + y[q][1] * y[q][1]) + (y[q][2] * y[q][2] + y[q][3] * y[q][3]); }
                    const float rs = 1.0f / sqrtf(wave_sum(ss) * (1.0f / D) + EPS);
#pragma unroll
                    for (int q = 0; q < 16; ++q) { const f32x4 ca = *(const LAS f32x4*)(vA + lane_ * 4 + q * 256); x[q] = x[q] + ca * (y[q] * rs); }
                    if constexpr (MODE == 2) {
                        if (i >= CTXL) { float* orow = outp() + ((size_t)b * SEQ + (i - CTXL)) * D + lane_ * 4;
#pragma unroll
                            for (int q = 0; q < 16; ++q) *(f32x4*)(orow + q * 256) = x[q]; }
                    } else {
#pragma unroll
                        for (int q = 0; q < 16; ++q) *(f32x4*)(xr + q * 256) = x[q];
                    }
                }
                if constexpr (MODE != 2) {
                    float ss = 0.f;
#pragma unroll
                    for (int q = 0; q < 16; ++q) ss += (x[q][0] * x[q][0] + x[q][1] * x[q][1]) + (x[q][2] * x[q][2] + x[q][3] * x[q][3]);
                    const float rs = 1.0f / sqrtf(wave_sum(ss) * (1.0f / D) + EPS);
                    bf16* hr = H + (size_t)m * D + lane_ * 4;
#pragma unroll
                    for (int q = 0; q < 16; ++q) { const f32x4 cb = *(const LAS f32x4*)(vB + lane_ * 4 + q * 256), sh = *(const LAS f32x4*)(vS + lane_ * 4 + q * 256);
                        const f32x4 h = (x[q] * rs) * cb + sh;
                        v2u w; w.x = pk2(h[0], h[1]); w.y = pk2(h[2], h[3]); *(v2u*)(hr + q * 256) = w; }
                }
            }
        }
        ms = me;
    }
}
__device__ __forceinline__ void phase_qk(const Frame& F, const Args& A, int l) {
    const int tid_ = opaque_tid(), lane_ = tid_ & 63, wave_ = __builtin_amdgcn_readfirstlane(tid_ >> 6); (void)tid_; (void)lane_; (void)wave_;
    const int gw = F.vcu * 8 + wave_, NGW = F.G * 8;
    bf16* P = (bf16*)(F.ws + WS_PROJ); const float* rp = (const float*)(F.ws + WS_ROPE);
    const float* gq = inp(I_AQN) + l * HD; const float* gk = inp(I_AKN) + l * HD;
    for (int m = gw; m < M; m += NGW) {
        const int i = m % TPB; const bool lat = i >= CTXL; const int t = i - CTXL, prow = t >> 6, pcol = t & 63;
        bf16* row = P + (size_t)m * INW;
#pragma unroll
        for (int s = 0; s < 5; ++s) {
            const int col = s * 512 + lane_ * 8, d = col & 127;
            v4u w = *(const v4u*)(row + col);
            float v[8] = {bflo(w.x), bfhi(w.x), bflo(w.y), bfhi(w.y), bflo(w.z), bfhi(w.z), bflo(w.w), bfhi(w.w)};
            float ss = 0.f;
#pragma unroll
            for (int j = 0; j < 8; ++j) ss += v[j] * v[j];
            ss += __shfl_xor(ss, 1); ss += __shfl_xor(ss, 2); ss += __shfl_xor(ss, 4); ss += __shfl_xor(ss, 8);
            const float rs = 1.0f / sqrtf(ss * (1.0f / HD) + EPS);
            const float* g = (col < C_AK) ? gq : gk;
            const f32x4 g0 = *(const f32x4*)(g + d), g1 = *(const f32x4*)(g + d + 4);
#pragma unroll
            for (int j = 0; j < 4; ++j) { v[j] = v[j] * rs * g0[j]; v[4 + j] = v[4 + j] * rs * g1[j]; }
            if (lat) {
                const int p0 = d >> 1; const int pos = (p0 < 32) ? prow : pcol; const int fi = p0 & 31;
                const f32x4 cs = *(const f32x4*)(rp + pos * 32 + fi), sn = *(const f32x4*)(rp + 2048 + pos * 32 + fi);
#pragma unroll
                for (int j = 0; j < 4; ++j) { const float a = v[2 * j], b2 = v[2 * j + 1]; v[2 * j] = a * cs[j] - b2 * sn[j]; v[2 * j + 1] = a * sn[j] + b2 * cs[j]; }
            }
            w.x = pk2(v[0], v[1]); w.y = pk2(v[2], v[3]); w.z = pk2(v[4], v[5]); w.w = pk2(v[6], v[7]);
            *(v4u*)(row + col) = w;
        }
        if (lat) {
#pragma unroll
            for (int s = 0; s < 4; ++s) {
                const int col = C_CQ + s * 512 + lane_ * 8, d = col & 63;
                v4u w = *(const v4u*)(row + col);
                float v[8] = {bflo(w.x), bfhi(w.x), bflo(w.y), bfhi(w.y), bflo(w.z), bfhi(w.z), bflo(w.w), bfhi(w.w)};
                const int p0 = d >> 1; const int pos = (p0 < 16) ? prow : pcol; const int fi = p0 & 15;
                const f32x4 cs = *(const f32x4*)(rp + 4096 + pos * 16 + fi), sn = *(const f32x4*)(rp + 4096 + 1024 + pos * 16 + fi);
#pragma unroll
                for (int j = 0; j < 4; ++j) { const float a = v[2 * j], b2 = v[2 * j + 1]; v[2 * j] = a * cs[j] - b2 * sn[j]; v[2 * j + 1] = a * sn[j] + b2 * cs[j]; }
                w.x = pk2(v[0], v[1]); w.y = pk2(v[2], v[3]); w.z = pk2(v[4], v[5]); w.w = pk2(v[6], v[7]);
                *(v4u*)(row + col) = w;
            }
        }
    }
}
__device__ __forceinline__ void phase_attn(const Frame& F, const Args& A, int l) {
    const int tid_ = opaque_tid(), lane_ = tid_ & 63, wave_ = __builtin_amdgcn_readfirstlane(tid_ >> 6); (void)tid_; (void)lane_; (void)wave_;
    char* lds = (char*)F.lds;
    const bf16* P = (const bf16*)(F.ws + WS_PROJ); bf16* MIX = (bf16*)(F.ws + WS_MIX);
    const bool last = (l == DEPTH - 1);
    if (PHM & 0x1000) {
        const int nU = 1024 + (last ? 0 : 96);
        for (int u = F.vcu; u < nU; u += F.G) {
            int b, qrow, kcol, vcol, qcol, ocol, nt;
            if (u < 1024) { const int qb = u & 15, hq = (u >> 4) & 15; b = u >> 8; qrow = CTXL + qb * 256; qcol = C_AQ + hq * HD; kcol = C_AK + (hq >> 2) * HD; vcol = C_AV + (hq >> 2) * HD; ocol = hq * HD; nt = TPB / 64; }
            else if (u < 1088) { const int v = u - 1024, hq = v & 15; b = v >> 4; qrow = 0; qcol = C_AQ + hq * HD; kcol = C_AK + (hq >> 2) * HD; vcol = C_AV + (hq >> 2) * HD; ocol = hq * HD; nt = CTXL / 64; }
            else { const int v = u - 1088, hb = v & 7; b = v >> 3; qrow = 0; qcol = C_BQ + hb * HD; kcol = C_BK + hb * HD; vcol = C_BV + hb * HD; ocol = 2048 + hb * HD; nt = CTXL / 64; }
            att::Tiles T; T.NT = nt; T.jmax = nt - 1; T.jsplit = 1 << 30; T.extra = 0; T.btab = nullptr; T.bmask = nullptr; T.bzero = nullptr; T.rlo = T.nrows = T.Rw = T.r0w = T.half = 0;
            const size_t rb = (size_t)b * TPB;
            f32x16 o[4];
            att::attn_core<0>(P, (unsigned)((rb + qrow) * INW + qcol), (unsigned)(rb * INW + kcol), (unsigned)(rb * INW + vcol), T, 0, lds, o);
            att::store_o_bf16(o, MIX + (rb + qrow) * D + ocol, lds);
        }
    }
    if (PHM & 0x2000) {
        for (int u = F.vcu; u < 512; u += F.G) {
            const int qb = u & 15, hb = (u >> 4) & 7, b = u >> 7;
            int rlo = 4 * qb - 4; rlo = rlo < 0 ? 0 : (rlo > 56 ? 56 : rlo);
            int rh = 4 * qb + 3 - 4; rh = rh < 0 ? 0 : (rh > 56 ? 56 : rh); const int nrows = rh + 8 - rlo;
            att::Tiles T; T.NT = (4 + nrows + 1) & ~1; T.jmax = 4 + nrows - 1; T.jsplit = 4; T.extra = rlo * 64;
            T.btab = (const float*)(F.ws + WS_BIAS) + (size_t)(l * 8 + hb) * 15 * 2 * 2048; T.bmask = (const float*)(F.ws + WS_BMASK); T.bzero = T.bmask + 2048;
            T.rlo = rlo; T.nrows = nrows; T.Rw = 4 * qb + (wave_ >> 1); { int r0 = T.Rw - 4; T.r0w = r0 < 0 ? 0 : (r0 > 56 ? 56 : r0); } T.half = wave_ & 1;
            const size_t rb = (size_t)b * TPB; const int qrow = CTXL + qb * 256;
            f32x16 o[4];
            att::attn_core<2>(P, (unsigned)((rb + qrow) * INW + C_BQ + hb * HD), (unsigned)(rb * INW + C_BK + hb * HD), (unsigned)(rb * INW + C_BV + hb * HD), T, 0, lds, o);
            att::store_o_bf16(o, MIX + (rb + qrow) * D + 2048 + hb * HD, lds);
        }
    }
    if (PHM & 0x4000) {
        const float lam = __hip_atomic_load((const float*)(F.ws + WS_LAM) + l, RLX_AGENT);
        const float lam_init = 0.8f - 0.6f * expf(-0.3f * (float)l);
        float* scr = (float*)(F.ws + WS_Y) + (size_t)blockIdx.x * 32768 + wave_ * 4096 + lane_ * 64;
        const float* gs = inp(I_SUBLN) + l * HD;
        const int nU = 512 + (last ? 0 : 32);
        for (int u = F.vcu; u < nU; u += F.G) {
            int b, hc, qrow, nt;
            if (u < 512) { const int qb = u & 15; hc = (u >> 4) & 7; b = u >> 7; qrow = CTXL + qb * 256; nt = TPB / 64; }
            else { const int v = u - 512; hc = v & 7; b = v >> 3; qrow = 0; nt = CTXL / 64; }
            att::Tiles T; T.NT = nt; T.jmax = nt - 1; T.jsplit = 1 << 30; T.extra = 0; T.btab = nullptr; T.bmask = nullptr; T.bzero = nullptr; T.rlo = T.nrows = T.Rw = T.r0w = T.half = 0;
            const size_t rb = (size_t)b * TPB;
#pragma unroll 1
            for (int comp = 0; comp < 2; ++comp) {
                f32x16 o[4];
                att::attn_core<1>(P, (unsigned)((rb + qrow) * INW + C_CQ + hc * HD + comp * 64), (unsigned)(rb * INW + C_CK + hc * HD), (unsigned)(rb * INW + C_CV + hc * HD), T, comp * 128, lds, o);
                if (comp == 0) {
#pragma unroll
                    for (int d0 = 0; d0 < 4; ++d0)
#pragma unroll
                        for (int q = 0; q < 4; ++q) *(f32x4*)(scr + d0 * 16 + q * 4) = (f32x4){o[d0][4 * q], o[d0][4 * q + 1], o[d0][4 * q + 2], o[d0][4 * q + 3]};
                } else {
                    const int r32 = lane_ & 31;
#pragma unroll
                    for (int d0 = 0; d0 < 4; ++d0)
#pragma unroll
                        for (int q = 0; q < 4; ++q) { const f32x4 t = *(const f32x4*)(scr + d0 * 16 + q * 4);
#pragma unroll
                            for (int j = 0; j < 4; ++j) o[d0][4 * q + j] = t[j] - lam * o[d0][4 * q + j]; }
                    float gv[4];
#pragma unroll
                    for (int d0 = 0; d0 < 4; ++d0) gv[d0] = gs[d0 * 32 + r32] * (1.0f - lam_init);
#pragma unroll
                    for (int r = 0; r < 16; ++r) { float ss = (o[0][r] * o[0][r] + o[1][r] * o[1][r]) + (o[2][r] * o[2][r] + o[3][r] * o[3][r]);
                        ss += __shfl_xor(ss, 1); ss += __shfl_xor(ss, 2); ss += __shfl_xor(ss, 4); ss += __shfl_xor(ss, 8); ss += __shfl_xor(ss, 16);
                        const float rs = 1.0f / sqrtf(ss * (1.0f / HD) + EPS);
#pragma unroll
                        for (int d0 = 0; d0 < 4; ++d0) o[d0][r] = o[d0][r] * rs * gv[d0]; }
                    att::store_o_bf16(o, MIX + (rb + qrow) * D + 3072 + hc * HD, lds);
                }
            }
        }
    }
}

constexpr int NPH_LAYER = 9;
constexpr int NPHASES = 3 + DEPTH * NPH_LAYER;

__global__ void __launch_bounds__(512, 2) trunk_fwd(Args args) {
    extern __shared__ __attribute__((aligned(16))) unsigned char lds_raw[];
    Frame F;
    F.lds = (LAS unsigned char*)lds_raw; F.ws = args.ws;
    F.G = gridDim.x; { const int bx = blockIdx.x; F.vcu = (F.G % 8 == 0) ? (bx % 8) * (F.G / 8) + bx / 8 : bx; }
    volatile LAS unsigned* MISC = (volatile LAS unsigned*)(F.lds + MISC_OFF);
    if (threadIdx.x < 64) MISC[threadIdx.x] = 0u;
    __syncthreads();
    unsigned* ctl = (unsigned*)(args.ws + WS_CTL);
    XcdBarrier bar; bar.bar = ctl + CW_BAR; bar.x = 0; bar.st = nullptr;
#if MK_PER_PHASE
    const int lo = args.ph_lo, hi = args.ph_hi;
#else
    constexpr int lo = 0, hi = NPHASES;
#endif
    if (hi - lo > 1) bar = xcd_barrier_post(ctl + CW_BAR, MISC + 8);
#define IN(k) (lo <= (k) && (k) < hi)
#define SEAM(k) do { if (IN(k) && IN((k) + 1)) xcd_barrier(bar); } while (0)
    const float* MOD = (const float*)(args.ws + WS_MOD);

    if ((PHM & 1) && IN(0)) { _Pragma("unroll 1") for (int rep_ = 0; rep_ < ((PROBE_DUP >> 13) & 1 ? 2 : 1); ++rep_) phase_p0(F, args); } SEAM(0);
    if ((PHM & 2) && IN(1)) { phase_p1(F, args); } SEAM(1);
    if ((PHM & 4) && IN(2)) { _Pragma("unroll 1") for (int rep_ = 0; rep_ < ((PROBE_DUP >> 12) & 1 ? 9 : 1); ++rep_) phase_rows<0>(F, args, nullptr, nullptr, inp(I_NMPRE), MOD + 0 * D, MOD + 1 * D, false, false); } SEAM(2);

    for (int l = 0; l < DEPTH; ++l) {
        const int pb = 3 + l * NPH_LAYER;
        unsigned char* wb = args.ws + WS_W + (size_t)l * W_LAYER;
        const float* modl = MOD + (size_t)l * 5 * 6 * D;
        const bool last = (l == DEPTH - 1);
        if ((PHM & 8) && IN(pb + 0)) {
_Pragma("unroll 1") for (int rep_ = 0; rep_ < DUPN(0); ++rep_) {
            pg8::Gemm g{(const bf16*)(args.ws + WS_H), (const bf16*)(wb + W_IN), M, INW, D, D}; pg8::Sched S; if (last) S.init(64, INW / 256, D / 64, F.G, (int)blockIdx.x, 1, 0, 1, 0, 1); else S.init(68, INW / 256, D / 64, F.G, (int)blockIdx.x, 0, 0, 1, 0, 0);
            pg8::EpiBf16<0> E{(bf16*)(args.ws + WS_PROJ), INW, nullptr};
            pg8::gemm_phase<pg8::EpiBf16<0>, pg8::Sched>(F.lds, g, S, E);
        }
        } SEAM(pb + 0);
        if ((PHM & 16) && IN(pb + 1)) { phase_qk(F, args, l); } SEAM(pb + 1);
        if ((PHM & 32) && IN(pb + 2)) {
_Pragma("unroll 1") for (int rep_ = 0; rep_ < DUPN(2); ++rep_) {
            phase_attn(F, args, l);
            __syncthreads();
            if (PHM & 0x8000) {
            pg8::Gemm g{(const bf16*)(args.ws + WS_PROJ) + C_GL, (const bf16*)(wb + W_GATE), M, 3 * D, GRK, INW}; pg8::Sched S; S.init(last ? 64 : 68, 3 * D / 256, GRK / 64, F.G, (int)blockIdx.x, last ? 1 : 0, 0, 1, 0, 0);
            pg8::EpiBf16<2> E{(bf16*)(args.ws + WS_G), 3 * D, inp(I_BGATE) + (size_t)l * 3 * D};
            pg8::gemm_phase<pg8::EpiBf16<2>, pg8::Sched>(F.lds, g, S, E); }
        }
        } SEAM(pb + 2);
        if ((PHM & 64) && IN(pb + 3)) {
_Pragma("unroll 1") for (int rep_ = 0; rep_ < DUPN(3); ++rep_) {
            pg8::Gemm g{(const bf16*)(args.ws + WS_MIX), (const bf16*)(wb + W_BR), M, D, D, D}; pg8::Sched S; S.init(last ? 64 : 68, D / 256, D / 64, F.G, (int)blockIdx.x, last ? 1 : 0, 0, 1, 0, 0);
            pg8::EpiHorner E{(bf16*)(args.ws + WS_MRG), D, (const bf16*)(args.ws + WS_G)};
            pg8::gemm_phase<pg8::EpiHorner, pg8::Sched>(F.lds, g, S, E);
        }
        } SEAM(pb + 3);
        if ((PHM & 128) && IN(pb + 4)) {
_Pragma("unroll 1") for (int rep_ = 0; rep_ < DUPN(4); ++rep_) {
            pg8::Gemm g{(const bf16*)(args.ws + WS_MRG), (const bf16*)(wb + W_OUT), M, D, D, D}; pg8::Sched S; S.init(64, D / 256, D / 64, F.G, (int)blockIdx.x, last ? 1 : 0, last ? 0 : 4, 4, 64, 0);
            pg8::EpiY E{(bf16*)(args.ws + WS_Y), D, (float*)(args.ws + WS_YP), 64, (size_t)1024 * D};
            pg8::gemm_phase<pg8::EpiY, pg8::Sched>(F.lds, g, S, E);
        }
        } SEAM(pb + 4);
        if ((PHM & 256) && IN(pb + 5)) { phase_rows<1>(F, args, inp(I_NMPOST) + (size_t)l * D, modl + 2 * D, inp(I_NFPRE) + (size_t)l * D, modl + 3 * D, modl + 4 * D, last, !last); } SEAM(pb + 5);
        if ((PHM & 512) && IN(pb + 6)) {
_Pragma("unroll 1") for (int rep_ = 0; rep_ < DUPN(6); ++rep_) {
            pg8::Gemm g{(const bf16*)(args.ws + WS_H), (const bf16*)(wb + W_FFI), M, 2 * DFF, D, D}; pg8::Sched S; S.init(last ? 64 : 68, 2 * DFF / 256, D / 64, F.G, (int)blockIdx.x, last ? 1 : 0, 0, 1, 0, 0);
            pg8::EpiSwiGLU E{(bf16*)(args.ws + WS_ACT), DFF};
            pg8::gemm_phase<pg8::EpiSwiGLU, pg8::Sched>(F.lds, g, S, E);
        }
        } SEAM(pb + 6);
        if ((PHM & 1024) && IN(pb + 7)) {
_Pragma("unroll 1") for (int rep_ = 0; rep_ < DUPN(7); ++rep_) {
            pg8::Gemm g{(const bf16*)(args.ws + WS_ACT), (const bf16*)(wb + W_FFO), M, D, DFF, DFF}; pg8::Sched S; S.init(64, D / 256, DFF / 64, F.G, (int)blockIdx.x, last ? 1 : 0, last ? 0 : 4, 4, 64, 0);
            pg8::EpiY E{(bf16*)(args.ws + WS_Y), D, (float*)(args.ws + WS_YP), 64, (size_t)1024 * D};
            pg8::gemm_phase<pg8::EpiY, pg8::Sched>(F.lds, g, S, E);
        }
        } SEAM(pb + 7);
        if ((PHM & 2048) && IN(pb + 8)) {
            if (l < DEPTH - 1) phase_rows<1>(F, args, inp(I_NFPOST) + (size_t)l * D, modl + 5 * D, inp(I_NMPRE) + (size_t)(l + 1) * D, modl + 5 * 6 * D + 0 * D, modl + 5 * 6 * D + 1 * D, false, true);
            else phase_rows<2>(F, args, inp(I_NFPOST) + (size_t)l * D, modl + 5 * D, nullptr, nullptr, nullptr, true, false);
        } SEAM(pb + 8);
    }
#undef IN
#undef SEAM
}

extern "C" void kernel_launch(void* const* d_in, const int* in_sizes, int n_in, void* d_out, int out_size, void* d_ws, size_t ws_size, hipStream_t stream) {
    static int grid = 0;
    if (grid == 0) {
        if (n_in != 26 || in_sizes[0] != NB * SEQ * D || out_size != NB * SEQ * D || ws_size < WS_END) { fprintf(stderr, "kernel_launch: shape mismatch (n_in %d, in0 %d, out %d, ws %zu < %zu)\n", n_in, n_in > 0 ? in_sizes[0] : -1, out_size, ws_size, (size_t)WS_END); grid = -1; return; }
        int dev = 0, cus = 0, per_cu = 0;
        if (hipGetDevice(&dev) != hipSuccess || hipDeviceGetAttribute(&cus, hipDeviceAttributeMultiprocessorCount, dev) != hipSuccess) { grid = -1; return; }
        if (hipFuncSetAttribute((const void*)trunk_fwd, hipFuncAttributeMaxDynamicSharedMemorySize, LDS_BYTES) != hipSuccess) { fprintf(stderr, "kernel_launch: hipFuncSetAttribute failed\n"); grid = -1; return; }
        if (hipOccupancyMaxActiveBlocksPerMultiprocessor(&per_cu, (const void*)trunk_fwd, 512, LDS_BYTES) != hipSuccess || per_cu < 1) fprintf(stderr, "kernel_launch: occupancy query says %d\n", per_cu);
        (void)hipGetLastError();
        grid = cus;
    }
    if (grid < 0) return;
    (void)hipMemsetAsync((char*)d_ws + WS_CTL, 0, CTL_ZERO_BYTES, stream);
    Args a{};
    for (int i = 0; i < 26; ++i) a.in[i] = (const float*)d_in[i];
    a.out = (float*)d_out; a.ws = (unsigned char*)d_ws; a.pad = 0;
#if MK_PER_PHASE
    for (int p = 0; p < NPHASES; ++p) { a.ph_lo = p; a.ph_hi = p + 1; a.li = 0; hipLaunchKernelGGL(trunk_fwd, dim3(grid), dim3(512), LDS_BYTES, stream, a); }
#else
    a.ph_lo = 0; a.ph_hi = NPHASES; a.li = 0; hipLaunchKernelGGL(trunk_fwd, dim3(grid), dim3(512), LDS_BYTES, stream, a);
#endif
    const hipError_t le = hipPeekAtLastError();
    if (le != hipSuccess) fprintf(stderr, "kernel_launch: launch failed: %s\n", hipGetErrorName(le));
}
```
